# Optimizing an MI355X kernel written in HIP

```python
import math
import jax, jax.numpy as jnp
from jax import lax
import numpy as np

D_MODEL = 2048
BATCH = 8
SEQ = 4096
DEPTH = 4

N_MIXERS = 2
N_S5_LAYERS = (DEPTH + N_MIXERS - 1) // N_MIXERS
N_ATTN_LAYERS = DEPTH // N_MIXERS

S5_GROUP = 16
S5_GROUPS = D_MODEL // S5_GROUP
S5_STATE = 64
S5_DIRS = 2
S5_DT_MIN = 1e-3
S5_DT_MAX = 1e-1

HEAD_DIM = 64
N_Q_HEADS = D_MODEL // HEAD_DIM
N_KV_HEADS = 4
GQA_GROUP = N_Q_HEADS // N_KV_HEADS
WINDOW = 128
BLOCK = 128
ROPE_THETA = 10000.0

D_FF = 4 * D_MODEL

NORM_EPS = 1e-6
NEG_INF = -1e30

kernel_name = "hybrid_s5_swa_sqrelu_encoder"


def rms_norm(x, gain):
    xf = x.astype(jnp.float32)
    y = xf * lax.rsqrt(jnp.mean(xf * xf, axis=-1, keepdims=True) + NORM_EPS)
    return (y * gain.astype(jnp.float32)).astype(x.dtype)


def _ssm_combine(e1, e2):
    a1r, a1i, b1r, b1i = e1
    a2r, a2i, b2r, b2i = e2
    ar = a1r * a2r - a1i * a2i
    ai = a1r * a2i + a1i * a2r
    br = a2r * b1r - a2i * b1i + b2r
    bi = a2r * b1i + a2i * b1r + b2i
    return ar, ai, br, bi


def s5_mixer(u, a_re, a_im, log_step, b_re, b_im, c_re, c_im, d_skip, w_glu_a, w_glu_b):
    bsz, seq, dm = u.shape
    f32 = jnp.float32
    ar = a_re.astype(f32)
    ai = a_im.astype(f32)
    step = jnp.exp(log_step.astype(f32))[..., None]
    mag = jnp.exp(ar * step)
    lb_re = mag * jnp.cos(ai * step)
    lb_im = mag * jnp.sin(ai * step)
    den = ar * ar + ai * ai
    nr = lb_re - 1.0
    ni = lb_im
    f_re = (nr * ar + ni * ai) / den
    f_im = (ni * ar - nr * ai) / den
    br_ = b_re.astype(f32)
    bi_ = b_im.astype(f32)
    bb_re = f_re[..., None] * br_ - f_im[..., None] * bi_
    bb_im = f_re[..., None] * bi_ + f_im[..., None] * br_
    cr = c_re.astype(f32)
    ci = c_im.astype(f32)

    uf = u.astype(f32)
    ug = uf.reshape(bsz, seq, S5_GROUPS, S5_GROUP)
    state_shape = (seq, S5_GROUPS, S5_STATE)

    def per_example(ue):
        bu_re = jnp.einsum('lgh,ngph->nlgp', ue, bb_re)
        bu_im = jnp.einsum('lgh,ngph->nlgp', ue, bb_im)
        y = jnp.zeros((seq, S5_GROUPS, S5_GROUP), f32)
        for d, rev in ((0, False), (1, True)):
            elems = (jnp.broadcast_to(lb_re[d], state_shape),
                     jnp.broadcast_to(lb_im[d], state_shape),
                     bu_re[d], bu_im[d])
            _, _, s_re, s_im = lax.associative_scan(_ssm_combine, elems, reverse=rev, axis=0)
            y = y + jnp.einsum('lgp,ghp->lgh', s_re, cr[d]) - jnp.einsum('lgp,ghp->lgh', s_im, ci[d])
        return y

    y = lax.map(per_example, ug).reshape(bsz, seq, dm)
    y = y + d_skip.astype(f32) * uf
    z = jax.nn.gelu(y).astype(u.dtype)
    return (z @ w_glu_a) * jax.nn.sigmoid(z @ w_glu_b)


def head_rms_norm(x, gain):
    xf = x.astype(jnp.float32)
    y = xf * lax.rsqrt(jnp.mean(xf * xf, axis=-1, keepdims=True) + NORM_EPS)
    return y * gain.astype(jnp.float32)


def apply_rotary(x, positions):
    half = HEAD_DIM // 2
    inv_freq = ROPE_THETA ** (-jnp.arange(0, half, dtype=jnp.float32) * 2.0 / HEAD_DIM)
    ang = positions.astype(jnp.float32)[..., None] * inv_freq
    cos = jnp.cos(ang)[:, :, None, :]
    sin = jnp.sin(ang)[:, :, None, :]
    x1 = x[..., :half]
    x2 = x[..., half:]
    return jnp.concatenate([x1 * cos - x2 * sin, x2 * cos + x1 * sin], axis=-1)


def windowed_gqa(h, positions, w_qkv, q_gain, k_gain, sink, w_o):
    bsz, seq, _ = h.shape
    nb = seq // BLOCK
    qkv = h @ w_qkv
    q_w = N_Q_HEADS * HEAD_DIM
    kv_w = N_KV_HEADS * HEAD_DIM
    q = qkv[..., :q_w].reshape(bsz, seq, N_Q_HEADS, HEAD_DIM)
    k = qkv[..., q_w:q_w + kv_w].reshape(bsz, seq, N_KV_HEADS, HEAD_DIM)
    v = qkv[..., q_w + kv_w:].reshape(bsz, seq, N_KV_HEADS, HEAD_DIM)
    q = apply_rotary(head_rms_norm(q, q_gain), positions).astype(h.dtype)
    k = apply_rotary(head_rms_norm(k, k_gain), positions).astype(h.dtype)

    q = q.reshape(bsz, nb, BLOCK, N_KV_HEADS, GQA_GROUP, HEAD_DIM)
    pad = ((0, 0), (BLOCK, BLOCK), (0, 0), (0, 0))
    kb = jnp.pad(k, pad).reshape(bsz, nb + 2, BLOCK, N_KV_HEADS, HEAD_DIM)
    vb = jnp.pad(v, pad).reshape(bsz, nb + 2, BLOCK, N_KV_HEADS, HEAD_DIM)
    k_win = jnp.concatenate([kb[:, :-2], kb[:, 1:-1], kb[:, 2:]], axis=2)
    v_win = jnp.concatenate([vb[:, :-2], vb[:, 1:-1], vb[:, 2:]], axis=2)

    scale = HEAD_DIM ** -0.5
    scores = jnp.einsum('bnqhgd,bnkhd->bnhgqk', q, k_win).astype(jnp.float32) * scale

    q_idx = jnp.arange(BLOCK)[:, None]
    k_off = jnp.arange(3 * BLOCK)[None, :] - BLOCK
    band = jnp.abs(k_off - q_idx) <= WINDOW
    key_abs = jnp.arange(nb)[:, None] * BLOCK + k_off
    in_range = (key_abs >= 0) & (key_abs < seq)
    mask = band[None, :, :] & in_range[:, None, :]
    scores = jnp.where(mask[None, :, None, None, :, :], scores, NEG_INF)

    sink_b = sink.astype(jnp.float32).reshape(1, 1, N_KV_HEADS, GQA_GROUP, 1, 1)
    m = jnp.maximum(jnp.max(scores, axis=-1, keepdims=True), sink_b)
    p = jnp.exp(scores - m)
    denom = jnp.sum(p, axis=-1, keepdims=True) + jnp.exp(sink_b - m)
    probs = (p / denom).astype(h.dtype)
    out = jnp.einsum('bnhgqk,bnkhd->bnqhgd', probs, v_win)
    return out.reshape(bsz, seq, q_w) @ w_o


def sqrelu_mlp(h, w_up, w_down):
    return jnp.square(jax.nn.relu(h @ w_up)) @ w_down


def setup_inputs(seed: int = 0) -> dict:
    key = jax.random.key(seed)
    ks = jax.random.split(key, 24)
    f32 = jnp.float32
    nrm = lambda k, shape, s: jax.random.normal(k, shape, f32) * s

    x = jax.random.normal(ks[0], (BATCH, SEQ, D_MODEL), f32)
    offsets = jax.random.randint(ks[1], (BATCH, 1), 0, 1024, jnp.int32)
    positions = (jnp.arange(SEQ, dtype=jnp.int32)[None, :] + offsets).astype(jnp.int32)

    ns, na = N_S5_LAYERS, N_ATTN_LAYERS
    gp = (ns, S5_DIRS, S5_GROUPS, S5_STATE)
    s5_norm = 1.0 + nrm(ks[2], (ns, D_MODEL), 0.02)
    s5_a_re = -0.5 + nrm(ks[3], gp, 0.01)
    s5_a_im = math.pi * jnp.arange(S5_STATE, dtype=f32) + nrm(ks[4], gp, 0.01)
    s5_log_step = jax.random.uniform(ks[5], (ns, S5_DIRS, S5_GROUPS), f32,
                                     math.log(S5_DT_MIN), math.log(S5_DT_MAX))
    bshape = (ns, S5_DIRS, S5_GROUPS, S5_STATE, S5_GROUP)
    s5_b_re = nrm(ks[6], bshape, (2 * S5_GROUP) ** -0.5)
    s5_b_im = nrm(ks[7], bshape, (2 * S5_GROUP) ** -0.5)
    cshape = (ns, S5_DIRS, S5_GROUPS, S5_GROUP, S5_STATE)
    s5_c_re = nrm(ks[8], cshape, S5_STATE ** -0.5)
    s5_c_im = nrm(ks[9], cshape, S5_STATE ** -0.5)
    s5_d = nrm(ks[10], (ns, D_MODEL), 1.0)
    s5_w_glu_a = nrm(ks[11], (ns, D_MODEL, D_MODEL), D_MODEL ** -0.5)
    s5_w_glu_b = nrm(ks[12], (ns, D_MODEL, D_MODEL), D_MODEL ** -0.5)

    qkv_w = (N_Q_HEADS + 2 * N_KV_HEADS) * HEAD_DIM
    attn_norm = 1.0 + nrm(ks[13], (na, D_MODEL), 0.02)
    attn_w_qkv = nrm(ks[14], (na, D_MODEL, qkv_w), D_MODEL ** -0.5)
    attn_q_gain = 1.0 + nrm(ks[15], (na, HEAD_DIM), 0.02)
    attn_k_gain = 1.0 + nrm(ks[16], (na, HEAD_DIM), 0.02)
    attn_sink = nrm(ks[17], (na, N_Q_HEADS), 0.5)
    attn_w_o = nrm(ks[18], (na, N_Q_HEADS * HEAD_DIM, D_MODEL), (N_Q_HEADS * HEAD_DIM) ** -0.5)

    mlp_norm = 1.0 + nrm(ks[19], (DEPTH, D_MODEL), 0.02)
    mlp_w_up = nrm(ks[20], (DEPTH, D_MODEL, D_FF), D_MODEL ** -0.5)
    mlp_w_down = nrm(ks[21], (DEPTH, D_FF, D_MODEL), D_FF ** -0.5)

    return {"x": x, "positions": positions,
            "s5_norm": s5_norm, "s5_a_re": s5_a_re, "s5_a_im": s5_a_im,
            "s5_log_step": s5_log_step, "s5_b_re": s5_b_re, "s5_b_im": s5_b_im,
            "s5_c_re": s5_c_re, "s5_c_im": s5_c_im, "s5_d": s5_d,
            "s5_w_glu_a": s5_w_glu_a, "s5_w_glu_b": s5_w_glu_b,
            "attn_norm": attn_norm, "attn_w_qkv": attn_w_qkv,
            "attn_q_gain": attn_q_gain, "attn_k_gain": attn_k_gain,
            "attn_sink": attn_sink, "attn_w_o": attn_w_o,
            "mlp_norm": mlp_norm, "mlp_w_up": mlp_w_up, "mlp_w_down": mlp_w_down}


def reference(x, positions, s5_norm, s5_a_re, s5_a_im, s5_log_step, s5_b_re, s5_b_im,
              s5_c_re, s5_c_im, s5_d, s5_w_glu_a, s5_w_glu_b, attn_norm, attn_w_qkv,
              attn_q_gain, attn_k_gain, attn_sink, attn_w_o, mlp_norm, mlp_w_up,
              mlp_w_down):
    h = x
    for i in range(DEPTH):
        j = i // N_MIXERS
        if i % N_MIXERS == 0:
            h = h + s5_mixer(rms_norm(h, s5_norm[j]), s5_a_re[j], s5_a_im[j], s5_log_step[j],
                             s5_b_re[j], s5_b_im[j], s5_c_re[j], s5_c_im[j], s5_d[j],
                             s5_w_glu_a[j], s5_w_glu_b[j])
        else:
            h = h + windowed_gqa(rms_norm(h, attn_norm[j]), positions, attn_w_qkv[j],
                                 attn_q_gain[j], attn_k_gain[j], attn_sink[j], attn_w_o[j])
        h = h + sqrelu_mlp(rms_norm(h, mlp_norm[i]), mlp_w_up[i], mlp_w_down[i])
    return h
```

```cpp
#include <hip/hip_runtime.h>
#include <hip/hip_cooperative_groups.h>
#include <cstdio>
#include <cstdint>
namespace cg = cooperative_groups;
#ifndef REP_P0
#define REP_P0 1
#endif
#ifndef REP_NORM
#define REP_NORM 1
#endif
#ifndef REP_TAB
#define REP_TAB 1
#endif
#ifndef REP_CARRY
#define REP_CARRY 1
#endif
#ifndef REP_S5G
#define REP_S5G 1
#endif
#ifndef REP_ATTN
#define REP_ATTN 1
#endif
#ifndef REP_QKV
#define REP_QKV 1
#endif
#ifndef REP_UP
#define REP_UP 1
#endif
#ifndef REP_SYNC
#define REP_SYNC 1
#endif
#define GSYNC() do { for (int _r = 0; _r < REP_SYNC; ++_r) xcd_barrier(xbar); } while (0)

#define LAS __attribute__((address_space(3)))
typedef unsigned short bf16_t;
typedef short bf16x8 __attribute__((ext_vector_type(8)));
typedef float f32x4 __attribute__((ext_vector_type(4)));
typedef float f32x2 __attribute__((ext_vector_type(2)));
typedef float f32x16 __attribute__((ext_vector_type(16)));
typedef unsigned u32x4 __attribute__((ext_vector_type(4)));
typedef unsigned u32x2 __attribute__((ext_vector_type(2)));
typedef unsigned long long u64;
constexpr size_t SS_USE = (size_t)64 * 32768;
constexpr int RS_OFF = 131072;

constexpr int BATCH = 8, SEQ = 4096, DM = 2048, MTOK = BATCH * SEQ, DFF = 8192, NQKV = 2560;
constexpr int S5T = 32;
constexpr int AGLD = 768;
constexpr int NWAVES = 8, NTHR = 512;
constexpr int LDS_BYTES = 147456;

constexpr size_t MiB = 1u << 20;
constexpr size_t WS_WUP = 1 * MiB, WS_WDN = 129 * MiB, WS_WGLU = 257 * MiB, WS_WQKV = 289 * MiB, WS_WO = 309 * MiB;
constexpr size_t WS_CS = 325 * MiB, WS_XN = 333 * MiB, WS_HID = 461 * MiB, WS_END = 973 * MiB;
constexpr size_t WS_AG = WS_HID, WS_BTY = WS_HID + 192 * MiB, WS_BTS = WS_HID + 288 * MiB, WS_SL = WS_HID + 320 * MiB;
constexpr size_t WS_Q = WS_HID, WS_KB = WS_HID + 128 * MiB, WS_VT = WS_HID + 144 * MiB, WS_AO = WS_HID + 160 * MiB;
constexpr size_t WS_Z = WS_SL;
constexpr size_t WS_SS = 973 * MiB;
constexpr size_t WS_END2 = 1021 * MiB;

__device__ __forceinline__ unsigned f2bf(float f) { unsigned u = __builtin_bit_cast(unsigned, f); return (u + 0x7fffu + ((u >> 16) & 1u)) >> 16; }
__device__ __forceinline__ unsigned pk2(float lo, float hi) { return f2bf(lo) | (f2bf(hi) << 16); }
__device__ __forceinline__ unsigned cvt_pk_bf16(float lo, float hi) { unsigned r; asm volatile("v_cvt_pk_bf16_f32 %0, %1, %2" : "=v"(r) : "v"(lo), "v"(hi)); return r; }
__device__ __forceinline__ float bf2f(unsigned b) { return __builtin_bit_cast(float, b << 16); }
__device__ __forceinline__ float wave_sum(float v) {
#pragma unroll
    for (int o = 1; o < 64; o <<= 1) v += __shfl_xor(v, o);
    return v;
}
__device__ __forceinline__ void sincos_d(double th, float& s, float& c) {
    double pio2 = 1.5707963267948966; asm volatile("" : "+s"(pio2));
    const float kf = rintf((float)th * 0.636619772f);
    const float t = (float)fma(-(double)kf, pio2, th);
    const float t2 = t * t;
    const float sp = t + t * t2 * (-1.6666654611e-1f + t2 * (8.3321608736e-3f + t2 * -1.9515295891e-4f));
    const float cp = 1.f - 0.5f * t2 + t2 * t2 * (4.166664568298827e-2f + t2 * (-1.388731625493765e-3f + t2 * 2.443315711809948e-5f));
    const int q = (int)kf & 3;
    s = (q == 0) ? sp : (q == 1) ? cp : (q == 2) ? -sp : -cp;
    c = (q == 0) ? cp : (q == 1) ? -sp : (q == 2) ? -cp : sp;
}

namespace pg8 {
constexpr int BM = 256, BK = 64, HALF = 128, HTB = HALF * BK * 2, STAGE_BYTES = 8 * HTB, NXCD = 8, WGM = 4;
__device__ __forceinline__ int lds_byte(int r, int c) { const int st = (r >> 4) * 2 + (c >> 5), rr = r & 15, cc = c & 31, ob = rr * 64 + cc * 2; return st * 1024 + (ob ^ (((ob >> 9) & 1) << 5)); }
__device__ __forceinline__ void stage_rc(int b, int& R, int& C) { const int st = b / 1024, sb = b % 1024, swz = sb ^ (((sb >> 9) & 1) << 5); R = (st >> 1) * 16 + swz / 64; C = (st & 1) * 32 + (swz % 64) / 2; }
__device__ __forceinline__ int perm32(int rho) { const int n = rho >> 4, i = rho & 15; return 8 * (i >> 2) + 4 * n + (i & 3); }

struct Unit { int pm, pn, pb; };
struct Gemm { const bf16_t* A; const bf16_t* Bt; int lda, ldb, K; int a_tiled; };

struct TileOrder {
    int nM, nN, nwg, G, c, bdiv;
    __device__ __forceinline__ void init(int nM_, int nN_, int G_, int c_, int bdiv_) { nM = nM_; nN = nN_; nwg = nM * nN; G = G_; c = c_; bdiv = bdiv_; }
    __device__ __forceinline__ bool next(int i, Unit& u) const {
        const long L = (long)i * G + c; if (L >= nwg) return false;
        int wgid = (int)L; { const int q = nwg / NXCD, r = nwg % NXCD, xcd = wgid % NXCD, off = wgid / NXCD; wgid = (xcd < r ? xcd * (q + 1) : r * (q + 1) + (xcd - r) * q) + off; }
        const int nig = WGM * nN, gid = wgid / nig, fm = gid * WGM, gsz = (nM - fm) < WGM ? (nM - fm) : WGM;
        u.pm = fm + ((wgid % nig) % gsz); u.pn = (wgid % nig) / gsz; u.pb = bdiv ? (u.pm / bdiv) * nN + u.pn : u.pn; return true;
    }
};

template <class Epi>
__device__ __forceinline__ void gemm_phase(LAS unsigned char* lds, const Gemm g, const TileOrder& S, const Epi& E) {
    int tid = threadIdx.x; asm volatile("" : "+v"(tid));
    const int wid = __builtin_amdgcn_readfirstlane(tid >> 6), lane = tid & 63, wr = wid >> 2, wc = wid & 3, fr = lane & 15, fq = lane >> 4;
    const int K = g.K, nt = K / BK;
    unsigned voffA[2], voffB[2];
#pragma unroll
    for (int i = 0; i < 2; ++i) { int R, C; stage_rc(tid * 16 + i * 8192, R, C); const int Rb = Epi::PERM ? ((R & ~31) + perm32(R & 31)) : R;
        voffA[i] = (unsigned)(R * (g.a_tiled ? 64 : g.lda) + C) * 2u; voffB[i] = (unsigned)(Rb * g.ldb + C) * 2u; }
    const size_t kstep = (size_t)(BK * 2);
    const size_t kstepA = g.a_tiled ? (size_t)32768 : kstep;
    const size_t hstepA = g.a_tiled ? (size_t)16384 : (size_t)HALF * g.lda * 2, tstepA = g.a_tiled ? (size_t)(g.K / 64) * 32768 : 2 * hstepA;
    const size_t hstepB = (size_t)HALF * g.ldb * 2, tstepB = 2 * hstepB;
    const unsigned ldsw = (unsigned)wid * 1024u;
    const int aoff = lds_byte(wr * 64 + fr, fq * 8), boff = lds_byte(wc * 32 + fr, fq * 8);
#define PG8_SA(b, h) (((b) * 2 + (h)) * HTB)
#define PG8_SB(b, h) ((4 + (b) * 2 + (h)) * HTB)
#define PG8_STAGE(bufoff, gbase, voff) do { _Pragma("unroll") for (int _i = 0; _i < 2; ++_i) \
        __builtin_amdgcn_global_load_lds((const unsigned*)((const char*)(gbase) + (voff)[_i]), (LAS unsigned*)(lds + (bufoff) + ldsw + _i * 8192), 16, 0, 0); } while (0)
#define PG8_LDA(dst, b, h) do { _Pragma("unroll") for (int m = 0; m < 4; ++m) _Pragma("unroll") for (int k = 0; k < 2; ++k) dst[m][k] = *(const LAS bf16x8*)(lds + PG8_SA(b, h) + aoff + m * 2048 + k * 1024); } while (0)
#define PG8_LDB(dst, b, h) do { _Pragma("unroll") for (int n = 0; n < 2; ++n) _Pragma("unroll") for (int k = 0; k < 2; ++k) dst[n][k] = *(const LAS bf16x8*)(lds + PG8_SB(b, h) + boff + n * 2048 + k * 1024); } while (0)
#define PG8_MMA(ai, bj, At, Bt) do { __builtin_amdgcn_s_setprio(1); _Pragma("unroll") for (int m = 0; m < 4; ++m) _Pragma("unroll") for (int n = 0; n < 2; ++n) _Pragma("unroll") for (int k = 0; k < 2; ++k) \
        acc[ai][bj][m][n] = __builtin_amdgcn_mfma_f32_16x16x32_bf16(Bt[n][k], At[m][k], acc[ai][bj][m][n], 0, 0, 0); __builtin_amdgcn_s_setprio(0); } while (0)
#define PG8_WAIT_V(n) asm volatile("s_waitcnt vmcnt(" #n ")" ::: "memory")
#define PG8_WAIT_L(n) asm volatile("s_waitcnt lgkmcnt(" #n ")" ::: "memory")
#define PG8_BAR __builtin_amdgcn_s_barrier()
#define PG8_SCHED __builtin_amdgcn_sched_barrier(0)
    Unit cur, nxt; int ui = 0; int estate = -1;
    if (!S.next(0, cur)) return;
    f32x4 acc[2][2][4][2];
#pragma unroll
    for (int a = 0; a < 2; ++a)
#pragma unroll
        for (int b = 0; b < 2; ++b)
#pragma unroll
            for (int m = 0; m < 4; ++m)
#pragma unroll
                for (int n = 0; n < 2; ++n) acc[a][b][m][n] = (f32x4){0.f, 0.f, 0.f, 0.f};
    bf16x8 At[4][2], B0[2][2], B1[2][2];
    const char* cA = (const char*)g.A + (size_t)cur.pm * tstepA; const char* cB = (const char*)g.Bt + (size_t)cur.pb * tstepB;
    PG8_STAGE(PG8_SB(0, 0), cB, voffB); PG8_STAGE(PG8_SB(0, 1), cB + hstepB, voffB); PG8_STAGE(PG8_SA(0, 0), cA, voffA); PG8_STAGE(PG8_SA(0, 1), cA + hstepA, voffA);
    if (wr == 1) PG8_BAR;
    PG8_WAIT_V(2); PG8_BAR;
    PG8_STAGE(PG8_SB(1, 0), cB + kstep, voffB); PG8_STAGE(PG8_SA(1, 0), cA + kstepA, voffA); PG8_STAGE(PG8_SB(1, 1), cB + hstepB + kstep, voffB);
    PG8_WAIT_V(6); PG8_BAR;
    for (;;) {
        const bool has_next = S.next(ui + 1, nxt);
        const char* nA = has_next ? (const char*)g.A + (size_t)nxt.pm * tstepA : cA; const char* nB = has_next ? (const char*)g.Bt + (size_t)nxt.pb * tstepB : cB;
        for (int t = 0; t < nt; t += 2) {
            const bool last = (t == nt - 2);
            const char* a1 = cA + (size_t)(t + 1) * kstepA;
            const char* a2 = last ? nA : cA + (size_t)(t + 2) * kstepA; const char* b2 = last ? nB : cB + (size_t)(t + 2) * kstep;
            const char* a3 = a2 + kstepA; const char* b3 = b2 + kstep;
            PG8_LDB(B0, 0, 0); PG8_LDB(B1, 0, 1); PG8_SCHED; PG8_LDA(At, 0, 0); PG8_STAGE(PG8_SA(1, 1), a1 + hstepA, voffA);
            PG8_WAIT_V(8); PG8_WAIT_L(0); PG8_BAR; PG8_MMA(0, 0, At, B0); PG8_MMA(0, 1, At, B1); PG8_BAR; PG8_SCHED;
            PG8_LDA(At, 0, 1); PG8_STAGE(PG8_SB(0, 0), b2, voffB); PG8_STAGE(PG8_SB(0, 1), b2 + hstepB, voffB); PG8_STAGE(PG8_SA(0, 0), a2, voffA);
            PG8_WAIT_V(8); PG8_WAIT_L(0); PG8_BAR; PG8_MMA(1, 0, At, B0); PG8_MMA(1, 1, At, B1); PG8_BAR; PG8_SCHED;
            PG8_LDB(B0, 1, 0); PG8_LDB(B1, 1, 1); PG8_SCHED; PG8_LDA(At, 1, 0); PG8_STAGE(PG8_SA(0, 1), a2 + hstepA, voffA);
            PG8_WAIT_V(8); PG8_WAIT_L(0); PG8_BAR; PG8_MMA(0, 0, At, B0); PG8_MMA(0, 1, At, B1); PG8_BAR; PG8_SCHED;
            PG8_LDA(At, 1, 1); PG8_STAGE(PG8_SB(1, 0), b3, voffB); PG8_STAGE(PG8_SB(1, 1), b3 + hstepB, voffB); PG8_STAGE(PG8_SA(1, 0), a3, voffA);
            PG8_WAIT_V(8); PG8_WAIT_L(0); PG8_BAR; PG8_MMA(1, 0, At, B0); PG8_MMA(1, 1, At, B1); PG8_BAR; PG8_SCHED;
        }
        if (wr == 0) PG8_BAR;
        E(acc, cur, wr, wc, fr, fq, lds, estate);
        if (!has_next) break;
#pragma unroll
        for (int a = 0; a < 2; ++a)
#pragma unroll
            for (int b = 0; b < 2; ++b)
#pragma unroll
                for (int m = 0; m < 4; ++m)
#pragma unroll
                    for (int n = 0; n < 2; ++n) acc[a][b][m][n] = (f32x4){0.f, 0.f, 0.f, 0.f};
        cur = nxt; cA = nA; cB = nB; ++ui;
        if (wr == 1) PG8_BAR;
    }
    PG8_WAIT_V(0);
    PG8_BAR;
#undef PG8_SA
#undef PG8_SB
#undef PG8_STAGE
#undef PG8_LDA
#undef PG8_LDB
#undef PG8_MMA
#undef PG8_WAIT_V
#undef PG8_WAIT_L
#undef PG8_BAR
#undef PG8_SCHED
}

__device__ __forceinline__ void panel_rstd(LAS unsigned char* lds, const float* ssp, int nslot, int pm, int& estate) {
    if (pm != estate) {
        estate = pm;
        int t = threadIdx.x; asm volatile("" : "+v"(t));
        const int row = t >> 1, half = t & 1, hs = nslot >> 1;
        const float* p = ssp + (size_t)(half * hs) * MTOK + pm * 256 + row;
        float v[16]; float sum = 0.f;
#pragma unroll
        for (int q = 0; q < 16; ++q) v[q] = p[(size_t)q * MTOK];
        __builtin_amdgcn_sched_barrier(0);
#pragma unroll
        for (int q = 0; q < 16; ++q) sum += v[q];
        if (hs == 32) {
            __builtin_amdgcn_sched_barrier(0);
#pragma unroll
            for (int q = 0; q < 16; ++q) v[q] = p[(size_t)(16 + q) * MTOK];
            __builtin_amdgcn_sched_barrier(0);
#pragma unroll
            for (int q = 0; q < 16; ++q) sum += v[q];
        }
        sum += __shfl_xor(sum, 1);
        if (half == 0) ((LAS float*)(lds + RS_OFF))[row] = __builtin_amdgcn_rsqf(sum * (1.f / DM) + 1e-6f);
        asm volatile("s_waitcnt lgkmcnt(0)" ::: "memory"); __builtin_amdgcn_s_barrier(); asm volatile("" ::: "memory");
    }
}

struct EpiSqRelu {
    static constexpr bool PERM = true;
    bf16_t* O; int ldc; const float* ssp; int nslot;
    __device__ __forceinline__ void operator()(const f32x4 (&acc)[2][2][4][2], const Unit& u, int wr, int wc, int fr, int fq, LAS unsigned char* lds, int& estate) const {
        asm volatile("" : "+v"(fr), "+v"(fq));
        const int row0 = u.pm * BM + wr * 64 + fr, col0 = u.pn * BM + wc * 32 + 8 * fq;
        panel_rstd(lds, ssp, nslot, u.pm, estate);
        float rs[2][4];
#pragma unroll
        for (int ai = 0; ai < 2; ++ai)
#pragma unroll
            for (int m = 0; m < 4; ++m) rs[ai][m] = ((const LAS float*)(lds + RS_OFF))[wr * 64 + fr + ai * HALF + m * 16];
#pragma unroll
        for (int ai = 0; ai < 2; ++ai)
#pragma unroll
            for (int m = 0; m < 4; ++m) {
                bf16_t* rowp = O + (((size_t)u.pm * (DFF / 64) + (u.pn * 4 + (wc >> 1))) * 256 + (wr * 64 + fr + ai * HALF + m * 16)) * 64 + (wc & 1) * 32 + 8 * fq;
                const float r_ = rs[ai][m];
#pragma unroll
                for (int bj = 0; bj < 2; ++bj) { f32x4 v0 = acc[ai][bj][m][0] * r_, v1 = acc[ai][bj][m][1] * r_;
                    v0 = __builtin_elementwise_max(v0, (f32x4){0.f, 0.f, 0.f, 0.f}); v1 = __builtin_elementwise_max(v1, (f32x4){0.f, 0.f, 0.f, 0.f});
                    v0 = v0 * v0; v1 = v1 * v1;
                    u32x4 w; w.x = cvt_pk_bf16(v0[0], v0[1]); w.y = cvt_pk_bf16(v0[2], v0[3]); w.z = cvt_pk_bf16(v1[0], v1[1]); w.w = cvt_pk_bf16(v1[2], v1[3]);
                    __builtin_nontemporal_store(w, (u32x4*)(rowp + (size_t)bj * 2 * 256 * 64)); } }
    }
};
struct EpiResidual {
    static constexpr bool PERM = true;
    bf16_t* HB; float* SS; float* OUT;
    __device__ __forceinline__ void operator()(const f32x4 (&acc)[2][2][4][2], const Unit& u, int wr, int wc, int fr, int fq, LAS unsigned char* lds, int& estate) const {
        asm volatile("" : "+v"(fr), "+v"(fq));
        const int row0 = u.pm * BM + wr * 64 + fr, col0 = u.pn * BM + wc * 32 + 8 * fq;
        u32x4 t[2][4][2];
#pragma unroll
        for (int ai = 0; ai < 2; ++ai)
#pragma unroll
            for (int m = 0; m < 4; ++m)
#pragma unroll
                for (int bj = 0; bj < 2; ++bj) t[ai][m][bj] = *(const u32x4*)(HB + (size_t)(row0 + ai * HALF + m * 16) * DM + col0 + bj * HALF);
#pragma unroll
        for (int ai = 0; ai < 2; ++ai)
#pragma unroll
            for (int m = 0; m < 4; ++m) {
                const size_t off = (size_t)(row0 + ai * HALF + m * 16) * DM + col0;
                float q = 0.f;
#pragma unroll
                for (int bj = 0; bj < 2; ++bj) {
                    const u32x4 w_ = t[ai][m][bj];
                    f32x4 o0 = acc[ai][bj][m][0], o1 = acc[ai][bj][m][1];
                    o0[0] += bf2f(w_.x & 0xffffu); o0[1] += bf2f(w_.x >> 16); o0[2] += bf2f(w_.y & 0xffffu); o0[3] += bf2f(w_.y >> 16);
                    o1[0] += bf2f(w_.z & 0xffffu); o1[1] += bf2f(w_.z >> 16); o1[2] += bf2f(w_.w & 0xffffu); o1[3] += bf2f(w_.w >> 16);
                    if (OUT) { __builtin_nontemporal_store(o0, (f32x4*)(OUT + off + bj * HALF)); __builtin_nontemporal_store(o1, (f32x4*)(OUT + off + bj * HALF + 4)); }
                    else { u32x4 w; w.x = cvt_pk_bf16(o0[0], o0[1]); w.y = cvt_pk_bf16(o0[2], o0[3]); w.z = cvt_pk_bf16(o1[0], o1[1]); w.w = cvt_pk_bf16(o1[2], o1[3]);
                        *(u32x4*)(HB + off + bj * HALF) = w; }
                    q += ((o0[0] * o0[0] + o0[1] * o0[1]) + (o0[2] * o0[2] + o0[3] * o0[3])) + ((o1[0] * o1[0] + o1[1] * o1[1]) + (o1[2] * o1[2] + o1[3] * o1[3])); }
                if (SS) { q += __shfl_xor(q, 16); q += __shfl_xor(q, 32); if (fq == 0) SS[(size_t)(u.pn * 4 + wc) * MTOK + row0 + ai * HALF + m * 16] = q; }
            }
        asm volatile("" ::: "memory");
    }
};
struct EpiGlu {
    static constexpr bool PERM = true;
    bf16_t* HB; float* SS;
    __device__ __forceinline__ void operator()(const f32x4 (&acc)[2][2][4][2], const Unit& u, int wr, int wc, int fr, int fq, LAS unsigned char* lds, int& estate) const {
        asm volatile("" : "+v"(fr), "+v"(fq));
        const int row0 = u.pm * BM + wr * 64 + fr, col0 = u.pn * HALF + wc * 32 + 8 * fq;
        u32x4 t[2][4];
#pragma unroll
        for (int ai = 0; ai < 2; ++ai)
#pragma unroll
            for (int m = 0; m < 4; ++m) t[ai][m] = *(const u32x4*)(HB + (size_t)(row0 + ai * HALF + m * 16) * DM + col0);
#pragma unroll
        for (int ai = 0; ai < 2; ++ai)
#pragma unroll
            for (int m = 0; m < 4; ++m) {
                const u32x4 w_ = t[ai][m];
                f32x4 o[2];
                o[0][0] = bf2f(w_.x & 0xffffu); o[0][1] = bf2f(w_.x >> 16); o[0][2] = bf2f(w_.y & 0xffffu); o[0][3] = bf2f(w_.y >> 16);
                o[1][0] = bf2f(w_.z & 0xffffu); o[1][1] = bf2f(w_.z >> 16); o[1][2] = bf2f(w_.w & 0xffffu); o[1][3] = bf2f(w_.w >> 16);
#pragma unroll
                for (int n = 0; n < 2; ++n) { const f32x4 av = acc[ai][0][m][n], bv = acc[ai][1][m][n];
#pragma unroll
                    for (int e = 0; e < 4; ++e) o[n][e] += av[e] * __builtin_amdgcn_rcpf(1.f + __expf(-bv[e])); }
                u32x4 w; w.x = cvt_pk_bf16(o[0][0], o[0][1]); w.y = cvt_pk_bf16(o[0][2], o[0][3]); w.z = cvt_pk_bf16(o[1][0], o[1][1]); w.w = cvt_pk_bf16(o[1][2], o[1][3]);
                *(u32x4*)(HB + (size_t)(row0 + ai * HALF + m * 16) * DM + col0) = w;
                float q = ((o[0][0] * o[0][0] + o[0][1] * o[0][1]) + (o[0][2] * o[0][2] + o[0][3] * o[0][3])) + ((o[1][0] * o[1][0] + o[1][1] * o[1][1]) + (o[1][2] * o[1][2] + o[1][3] * o[1][3]));
                q += __shfl_xor(q, 16); q += __shfl_xor(q, 32); if (fq == 0) SS[(size_t)(u.pn * 4 + wc) * MTOK + row0 + ai * HALF + m * 16] = q;
            }
        asm volatile("" ::: "memory");
    }
};
struct EpiQKV {
    static constexpr bool PERM = false;
    bf16_t *Q, *Kb, *Vt; const float *qg, *kg, *cs, *ssp;
    __device__ __forceinline__ void operator()(const f32x4 (&acc)[2][2][4][2], const Unit& u, int wr, int wc, int fr, int fq, LAS unsigned char* lds, int& estate) const {
        asm volatile("" : "+v"(fr), "+v"(fq));
        const int pn = u.pn, row0 = u.pm * BM + wr * 64 + fr;
        panel_rstd(lds, ssp, 32, u.pm, estate);
        const LAS float* rsb = (const LAS float*)(lds + RS_OFF) + wr * 64 + fr;
        if (pn < 9) {
            const float* gain = pn < 8 ? qg : kg;
            const float osc = pn < 8 ? 0.125f * 1.44269504089f : 1.f;
            f32x4 g1[2], g2[2];
#pragma unroll
            for (int n = 0; n < 2; ++n) { g1[n] = *(const f32x4*)(gain + 16 * n + 4 * fq); g2[n] = *(const f32x4*)(gain + 32 + 16 * n + 4 * fq); }
            f32x4 cb[2][2], sb[2][2];
#define QKV_LOADCS(buf_, g_) do { _Pragma("unroll") for (int n = 0; n < 2; ++n) { \
                const size_t off = (size_t)(row0 + ((g_) >> 2) * HALF + ((g_) & 3) * 16) * 32 + 16 * n + 4 * fq; \
                cb[buf_][n] = *(const f32x4*)(cs + off); sb[buf_][n] = *(const f32x4*)(cs + (size_t)MTOK * 32 + off); } } while (0)
            QKV_LOADCS(0, 0);
            __builtin_amdgcn_sched_barrier(0);
            float rsv[2][4];
#pragma unroll
            for (int ai = 0; ai < 2; ++ai)
#pragma unroll
                for (int m = 0; m < 4; ++m) {
                    float ss = 0.f;
#pragma unroll
                    for (int bj = 0; bj < 2; ++bj)
#pragma unroll
                        for (int n = 0; n < 2; ++n) { const f32x4 v = acc[ai][bj][m][n]; ss += (v[0] * v[0] + v[1] * v[1]) + (v[2] * v[2] + v[3] * v[3]); }
                    rsv[ai][m] = ss;
                }
#pragma unroll
            for (int ai = 0; ai < 2; ++ai)
#pragma unroll
                for (int m = 0; m < 4; ++m) rsv[ai][m] += __shfl_xor(rsv[ai][m], 16);
#pragma unroll
            for (int ai = 0; ai < 2; ++ai)
#pragma unroll
                for (int m = 0; m < 4; ++m) rsv[ai][m] += __shfl_xor(rsv[ai][m], 32);
#pragma unroll
            for (int ai = 0; ai < 2; ++ai)
#pragma unroll
                for (int m = 0; m < 4; ++m) { const float rr = rsb[ai * HALF + m * 16]; rsv[ai][m] = __builtin_amdgcn_rsqf(rsv[ai][m] * rr * rr * (1.f / 64.f) + 1e-6f) * rr * osc; }
#pragma unroll
            for (int gq = 0; gq < 8; ++gq) {
                const int ai = gq >> 2, m = gq & 3;
                if (gq < 7) QKV_LOADCS((gq + 1) & 1, gq + 1);
                const int row = row0 + ai * HALF + m * 16;
                const float rs = rsv[ai][m];
                bf16_t* dst = pn < 8 ? (Q + (size_t)row * DM + (4 * pn + wc) * 64) : (Kb + (size_t)row * 256 + wc * 64);
#pragma unroll
                for (int n = 0; n < 2; ++n) {
                    const f32x4 c4 = cb[gq & 1][n], s4 = sb[gq & 1][n];
                    const f32x4 x1 = acc[ai][0][m][n] * rs * g1[n], x2 = acc[ai][1][m][n] * rs * g2[n];
                    const f32x4 y1 = x1 * c4 - x2 * s4, y2 = x2 * c4 + x1 * s4;
                    u32x2 w1, w2; w1.x = cvt_pk_bf16(y1[0], y1[1]); w1.y = cvt_pk_bf16(y1[2], y1[3]); w2.x = cvt_pk_bf16(y2[0], y2[1]); w2.y = cvt_pk_bf16(y2[2], y2[3]);
                    *(u32x2*)(dst + 16 * n + 4 * fq) = w1; *(u32x2*)(dst + 32 + 16 * n + 4 * fq) = w2;
                }
                asm volatile("" ::: "memory");
            }
#undef QKV_LOADCS
        } else {
#pragma unroll
            for (int ai = 0; ai < 2; ++ai)
#pragma unroll
                for (int m = 0; m < 4; ++m) {
                    const int row = row0 + ai * HALF + m * 16, b = row >> 12, l = row & 4095;
                    const float rr = rsb[ai * HALF + m * 16];
                    bf16_t* base = Vt + ((size_t)(b * 4 + wc) * 64) * SEQ + l;
#pragma unroll
                    for (int bj = 0; bj < 2; ++bj)
#pragma unroll
                        for (int n = 0; n < 2; ++n)
#pragma unroll
                            for (int e = 0; e < 4; ++e) base[(size_t)(32 * bj + 16 * n + 4 * fq + e) * SEQ] = (bf16_t)f2bf(acc[ai][bj][m][n][e] * rr);
                }
        }
    }
};
struct EpiS5S {
    static constexpr bool PERM = false;
    float* SL;
    __device__ __forceinline__ void operator()(const f32x4 (&acc)[2][2][4][2], const Unit& u, int wr, int wc, int fr, int fq, LAS unsigned char* lds, int& estate) const {
        asm volatile("" : "+v"(fr), "+v"(fq));
        const int row0 = u.pm * BM + wr * 64 + fr, col0 = wc * 32 + 4 * fq;
#pragma unroll
        for (int ai = 0; ai < 2; ++ai)
#pragma unroll
            for (int m = 0; m < 4; ++m) { float* rowp = SL + (size_t)(row0 + ai * HALF + m * 16) * 256 + col0;
#pragma unroll
                for (int bj = 0; bj < 2; ++bj)
#pragma unroll
                    for (int n = 0; n < 2; ++n) *(f32x4*)(rowp + bj * HALF + n * 16) = acc[ai][bj][m][n]; }
    }
};
struct EpiS5Y {
    static constexpr bool PERM = true;
    const bf16_t* AG; const float* dsk; bf16_t* Z;
    __device__ __forceinline__ void operator()(const f32x4 (&acc)[2][2][4][2], const Unit& u, int wr, int wc, int fr, int fq, LAS unsigned char* lds, int& estate) const {
        asm volatile("" : "+v"(fr), "+v"(fq));
        const int row0 = u.pm * BM + wr * 64 + fr, col0 = u.pn * BM + wc * 32 + 8 * fq;
        const int g = (u.pm * BM) >> 10;
        u32x4 uw[2][4][2]; f32x4 dd[2][2];
#pragma unroll
        for (int ai = 0; ai < 2; ++ai)
#pragma unroll
            for (int m = 0; m < 4; ++m)
#pragma unroll
                for (int bj = 0; bj < 2; ++bj) uw[ai][m][bj] = *(const u32x4*)(AG + (size_t)(row0 + ai * HALF + m * 16) * AGLD + col0 + bj * HALF);
#pragma unroll
        for (int bj = 0; bj < 2; ++bj) { const int ch = 16 * g + ((col0 + bj * HALF) & 15); dd[bj][0] = *(const f32x4*)(dsk + ch); dd[bj][1] = *(const f32x4*)(dsk + ch + 4); }
#pragma unroll
        for (int ai = 0; ai < 2; ++ai)
#pragma unroll
            for (int m = 0; m < 4; ++m) {
                const int r = row0 + ai * HALF + m * 16, b = (r >> 7) & 7, c = r & 127;
#pragma unroll
                for (int bj = 0; bj < 2; ++bj) {
                    const int cc = col0 + bj * HALF, i = cc >> 4, ho = cc & 15, ch = 16 * g + ho;
                    const u32x4 w_ = uw[ai][m][bj]; const f32x4 d0 = dd[bj][0], d1 = dd[bj][1];
                    f32x4 v0 = acc[ai][bj][m][0], v1 = acc[ai][bj][m][1];
                    v0[0] += d0[0] * bf2f(w_.x & 0xffffu); v0[1] += d0[1] * bf2f(w_.x >> 16); v0[2] += d0[2] * bf2f(w_.y & 0xffffu); v0[3] += d0[3] * bf2f(w_.y >> 16);
                    v1[0] += d1[0] * bf2f(w_.z & 0xffffu); v1[1] += d1[1] * bf2f(w_.z >> 16); v1[2] += d1[2] * bf2f(w_.w & 0xffffu); v1[3] += d1[3] * bf2f(w_.w >> 16);
#pragma unroll
                    for (int e = 0; e < 4; ++e) {
                        const float a0 = v0[e], a1 = v1[e];
                        v0[e] = a0 * __builtin_amdgcn_rcpf(1.f + __expf(-1.5957691216057308f * (a0 + 0.044715f * a0 * a0 * a0)));
                        v1[e] = a1 * __builtin_amdgcn_rcpf(1.f + __expf(-1.5957691216057308f * (a1 + 0.044715f * a1 * a1 * a1)));
                    }
                    u32x4 w; w.x = cvt_pk_bf16(v0[0], v0[1]); w.y = cvt_pk_bf16(v0[2], v0[3]); w.z = cvt_pk_bf16(v1[0], v1[1]); w.w = cvt_pk_bf16(v1[2], v1[3]);
                    *(u32x4*)(Z + ((size_t)(b * SEQ + c * S5T + i)) * DM + ch) = w;
                }
            }
        asm volatile("" ::: "memory");
    }
};
}

__device__ __forceinline__ void transpose_item(const float* W, int N, bf16_t* WT, int K, int drow, int k0, int n0, LAS float* scr, int lane, const float* kgain = nullptr) {
    float wv[32];
#pragma unroll
    for (int i = 0; i < 32; ++i) { const int kk = 2 * i + (lane >> 5); wv[i] = W[(size_t)(k0 + kk) * N + n0 + (lane & 31)]; }
    if (kgain) {
#pragma unroll
        for (int i = 0; i < 32; ++i) wv[i] *= kgain[k0 + 2 * i + (lane >> 5)];
    }
#pragma unroll
    for (int i = 0; i < 32; ++i) scr[(2 * i + (lane >> 5)) * 33 + (lane & 31)] = wv[i];
    asm volatile("s_waitcnt lgkmcnt(0)" ::: "memory");
    const int c = lane & 7;
#pragma unroll
    for (int j = 0; j < 4; ++j) { const int n = (lane >> 3) + 8 * j; const LAS float* s = scr + (8 * c) * 33 + n;
        u32x4 o; o.x = pk2(s[0 * 33], s[1 * 33]); o.y = pk2(s[2 * 33], s[3 * 33]); o.z = pk2(s[4 * 33], s[5 * 33]); o.w = pk2(s[6 * 33], s[7 * 33]);
        *(u32x4*)(WT + (size_t)(drow + n) * K + k0 + 8 * c) = o; }
    asm volatile("s_waitcnt lgkmcnt(0)" ::: "memory");
}

struct Args {
    const float* x; const int* pos;
    const float *s5_norm, *s5_are, *s5_aim, *s5_ls, *s5_bre, *s5_bim, *s5_cre, *s5_cim, *s5_d, *s5_wa, *s5_wb;
    const float *at_norm, *at_wqkv, *at_qg, *at_kg, *at_sink, *at_wo;
    const float *ml_norm, *ml_wup, *ml_wdn;
    float* out; unsigned char* ws;
};

__device__ __forceinline__ void convert_weights(const Args& a, LAS unsigned char* lds) {
    int tid = threadIdx.x; asm volatile("" : "+v"(tid));
    const int lane = tid & 63, wave = __builtin_amdgcn_readfirstlane(tid >> 6), G = gridDim.x, bx = blockIdx.x;
    const int gw = bx * NWAVES + wave, ngw = G * NWAVES, gtid = bx * NTHR + tid, ngt = G * NTHR; (void)lane; (void)gw; (void)ngw; (void)gtid; (void)ngt;
    LAS float* scr = (LAS float*)(lds + wave * 16384);
    bf16_t* WUP = (bf16_t*)(a.ws + WS_WUP); bf16_t* WDN = (bf16_t*)(a.ws + WS_WDN); bf16_t* WGLU = (bf16_t*)(a.ws + WS_WGLU);
    bf16_t* WQKV = (bf16_t*)(a.ws + WS_WQKV); bf16_t* WO = (bf16_t*)(a.ws + WS_WO);
    constexpr int I_UP = 32 * 256, I_DN = 128 * 64, I_GL = 32 * 64, I_QKV = 32 * 80, I_WO = 32 * 64;
    constexpr int NITEMS = 4 * I_UP + 4 * I_DN + 4 * I_GL + 2 * I_QKV + 2 * I_WO;
    for (int it = gw; it < NITEMS; it += ngw) {
        int r = it;
        if (r < 4 * I_UP) { const int l = r / I_UP; r -= l * I_UP; const int kb = r / 256, nb = r % 256;
            transpose_item(a.ml_wup + (size_t)l * DM * DFF, DFF, WUP + (size_t)l * DFF * DM, DM, 32 * nb, 64 * kb, 32 * nb, scr, lane, a.ml_norm + (size_t)l * DM); continue; }
        r -= 4 * I_UP;
        if (r < 4 * I_DN) { const int l = r / I_DN; r -= l * I_DN; const int kb = r / 64, nb = r % 64;
            transpose_item(a.ml_wdn + (size_t)l * DFF * DM, DM, WDN + (size_t)l * DM * DFF, DFF, 32 * nb, 64 * kb, 32 * nb, scr, lane); continue; }
        r -= 4 * I_DN;
        if (r < 4 * I_GL) { const int q = r / I_GL; r -= q * I_GL; const int j = q >> 1, isb = q & 1; const int kb = r / 64, nb = r % 64, n0 = 32 * nb;
            const float* W = (isb ? a.s5_wb : a.s5_wa) + (size_t)j * DM * DM;
            transpose_item(W, DM, WGLU + (size_t)j * 4096 * DM, DM, (n0 >> 7) * 256 + isb * 128 + (n0 & 127), 64 * kb, n0, scr, lane); continue; }
        r -= 4 * I_GL;
        if (r < 2 * I_QKV) { const int j = r / I_QKV; r -= j * I_QKV; const int kb = r / 80, nb = r % 80, n0 = 32 * nb, head = n0 >> 6, dblk = (n0 >> 5) & 1;
            transpose_item(a.at_wqkv + (size_t)j * DM * NQKV, NQKV, WQKV + (size_t)j * NQKV * DM, DM, (head >> 2) * 256 + dblk * 128 + (head & 3) * 32, 64 * kb, n0, scr, lane, a.at_norm + (size_t)j * DM); continue; }
        r -= 2 * I_QKV;
        { const int j = r / I_WO; r -= j * I_WO; const int kb = r / 64, nb = r % 64;
            transpose_item(a.at_wo + (size_t)j * DM * DM, DM, WO + (size_t)j * DM * DM, DM, 32 * nb, 64 * kb, 32 * nb, scr, lane); }
    }
}

__device__ __forceinline__ void norm_phase(const float* srcf, const bf16_t* srcb, bf16_t* copy_dst, const float* gain, bf16_t* dst) {
    int tid = threadIdx.x; asm volatile("" : "+v"(tid));
    const int lane = tid & 63, wave = __builtin_amdgcn_readfirstlane(tid >> 6), G = gridDim.x, bx = blockIdx.x;
    const int gw = bx * NWAVES + wave, ngw = G * NWAVES;
    f32x4 gf[8], gb[8];
#pragma unroll
    for (int j = 0; j < 8; ++j) gf[j] = *(const f32x4*)(gain + 4 * lane + 256 * j);
#pragma unroll
    for (int j = 0; j < 4; ++j) { gb[2 * j] = *(const f32x4*)(gain + 8 * lane + 512 * j); gb[2 * j + 1] = *(const f32x4*)(gain + 8 * lane + 512 * j + 4); }
    for (int m = gw; m < MTOK; m += ngw) {
        const int b = m >> 12, l = m & 4095;
        if (srcf) {
            const f32x4* xr = (const f32x4*)(srcf + (size_t)m * DM) + lane;
            f32x4 v[8]; float ss = 0.f;
#pragma unroll
            for (int j = 0; j < 8; ++j) v[j] = xr[64 * j];
            __builtin_amdgcn_sched_barrier(0);
#pragma unroll
            for (int j = 0; j < 8; ++j) ss += (v[j][0] * v[j][0] + v[j][1] * v[j][1]) + (v[j][2] * v[j][2] + v[j][3] * v[j][3]);
            ss = wave_sum(ss);
            const float rstd = 1.0f / sqrtf(ss * (1.f / DM) + 1e-6f);
#pragma unroll
            for (int j = 0; j < 8; ++j) {
                const int col = 4 * lane + 256 * j;
                u32x2 c; c.x = pk2(v[j][0], v[j][1]); c.y = pk2(v[j][2], v[j][3]);
                *(u32x2*)(copy_dst + (size_t)m * DM + col) = c;
                const f32x4 o = v[j] * rstd * gf[j];
                u32x2 w; w.x = pk2(o[0], o[1]); w.y = pk2(o[2], o[3]);
                const int gg = col >> 4, hh = col & 15; *(u32x2*)(dst + ((size_t)(gg * 1024 + b * 128 + (l >> 5))) * AGLD + (l & 31) * 16 + hh) = w;
            }
        } else {
            const u32x4* xr = (const u32x4*)(srcb + (size_t)m * DM) + lane;
            float v[4][8]; float ss = 0.f; u32x4 wl[4];
#pragma unroll
            for (int j = 0; j < 4; ++j) wl[j] = xr[64 * j];
            __builtin_amdgcn_sched_barrier(0);
#pragma unroll
            for (int j = 0; j < 4; ++j) { const u32x4 w_ = wl[j];
                v[j][0] = bf2f(w_.x & 0xffffu); v[j][1] = bf2f(w_.x >> 16); v[j][2] = bf2f(w_.y & 0xffffu); v[j][3] = bf2f(w_.y >> 16);
                v[j][4] = bf2f(w_.z & 0xffffu); v[j][5] = bf2f(w_.z >> 16); v[j][6] = bf2f(w_.w & 0xffffu); v[j][7] = bf2f(w_.w >> 16);
#pragma unroll
                for (int e = 0; e < 8; ++e) ss += v[j][e] * v[j][e]; }
            ss = wave_sum(ss);
            const float rstd = 1.0f / sqrtf(ss * (1.f / DM) + 1e-6f);
#pragma unroll
            for (int j = 0; j < 4; ++j) {
                const int col = 8 * lane + 512 * j;
                const f32x4 g0 = gb[2 * j], g1 = gb[2 * j + 1];
                u32x4 w; w.x = pk2(v[j][0] * rstd * g0[0], v[j][1] * rstd * g0[1]); w.y = pk2(v[j][2] * rstd * g0[2], v[j][3] * rstd * g0[3]);
                w.z = pk2(v[j][4] * rstd * g1[0], v[j][5] * rstd * g1[1]); w.w = pk2(v[j][6] * rstd * g1[2], v[j][7] * rstd * g1[3]);
                const int gg = col >> 4, hh = col & 15; *(u32x4*)(dst + ((size_t)(gg * 1024 + b * 128 + (l >> 5))) * AGLD + (l & 31) * 16 + hh) = w;
            }
        }
    }
}

__device__ __forceinline__ void cs_phase(const int* pos, float* cs) {
    int tid = threadIdx.x; asm volatile("" : "+v"(tid));
    const int lane = tid & 63, wave = __builtin_amdgcn_readfirstlane(tid >> 6), G = gridDim.x, bx = blockIdx.x;
    const int gw = bx * NWAVES + wave, ngw = G * NWAVES, gtid = bx * NTHR + tid, ngt = G * NTHR; (void)lane; (void)gw; (void)ngw; (void)gtid; (void)ngt;
    for (int idx = gtid; idx < MTOK * 32; idx += ngt) {
        const int m = idx >> 5, j = idx & 31;
        const double inv = (double)exp2f(-(float)j * (13.287712379549449f / 32.0f));
        float s, c; sincos_d((double)pos[m] * inv, s, c);
        cs[idx] = c; cs[(size_t)MTOK * 32 + idx] = s;
    }
}

__device__ __forceinline__ void s5_tables_item(LAS unsigned char* lds, const Args& a, int j, int g, int dir, bf16_t* BTY, bf16_t* BTS) {
    int tid = threadIdx.x; asm volatile("" : "+v"(tid));
    LAS f32x2* LAM = (LAS f32x2*)lds;
    LAS f32x2* FF = LAM + 128;
    LAS f32x2* BB = FF + 128;
    LAS f32x2* CC = BB + 2048;
    LAS f32x2* PW = CC + 2080;
    LAS float* KT = (LAS float*)(PW + 2112);
    LAS float* K0 = KT + 8192;
    __syncthreads();
    if (tid < 128) {
        const int d = tid >> 6, p = tid & 63;
        const size_t gi = ((size_t)(j * 2 + d) * 128 + g) * 64 + p;
        const float ar = a.s5_are[gi], ai = a.s5_aim[gi];
        const float step = expf(a.s5_ls[(size_t)(j * 2 + d) * 128 + g]);
        const float mag = expf(ar * step);
        float sn, cn; sincos_d((double)ai * (double)step, sn, cn);
        const float lre = mag * cn, lim = mag * sn;
        const float den = ar * ar + ai * ai, nr = lre - 1.f, ni = lim;
        LAM[tid] = (f32x2){lre, lim};
        FF[tid] = (f32x2){(nr * ar + ni * ai) / den, (ni * ar - nr * ai) / den};
    }
    for (int idx = tid; idx < 33 * 64; idx += NTHR) {
        const int k = idx >> 6, p = idx & 63;
        const size_t gi = ((size_t)(j * 2 + dir) * 128 + g) * 64 + p;
        const float ar = a.s5_are[gi], ai = a.s5_aim[gi];
        const float step = expf(a.s5_ls[(size_t)(j * 2 + dir) * 128 + g]);
        const float mag = expf((float)k * ar * step);
        float sn, cn; sincos_d((double)k * (double)ai * (double)step, sn, cn);
        PW[idx] = (f32x2){mag * cn, mag * sn};
    }
    __syncthreads();
    for (int idx = tid; idx < 2048; idx += NTHR) {
        const int d = idx >> 10, p = (idx >> 4) & 63, h = idx & 15;
        const size_t gi = (((size_t)(j * 2 + d) * 128 + g) * 64 + p) * 16 + h;
        const float br = a.s5_bre[gi], bi = a.s5_bim[gi];
        const f32x2 f = FF[d * 64 + p];
        BB[idx] = (f32x2){f.x * br - f.y * bi, f.x * bi + f.y * br};
    }
    for (int idx = tid; idx < 2048; idx += NTHR) {
        const int d = idx >> 10, h = (idx >> 6) & 15, p = idx & 63;
        const size_t gi = (((size_t)(j * 2 + d) * 128 + g) * 16 + h) * 64 + p;
        CC[(d * 16 + h) * 65 + p] = (f32x2){a.s5_cre[gi], a.s5_cim[gi]};
    }
    __syncthreads();
    {
        const int kh = tid >> 8, ho = (tid >> 4) & 15, hi = tid & 15;
        float ka[16]; float k0o = 0.f;
#pragma unroll
        for (int kk = 0; kk < 16; ++kk) ka[kk] = 0.f;
        for (int p = 0; p < 64; ++p) {
            const f32x2 c = CC[(dir * 16 + ho) * 65 + p], b = BB[(dir * 64 + p) * 16 + hi];
            const float cbr = c.x * b.x - c.y * b.y, cbi = c.x * b.y + c.y * b.x;
#pragma unroll
            for (int kk = 0; kk < 16; ++kk) { const f32x2 w = PW[(16 * kh + kk) * 64 + p]; ka[kk] += cbr * w.x - cbi * w.y; }
            const f32x2 c2 = CC[((1 - dir) * 16 + ho) * 65 + p], b2 = BB[((1 - dir) * 64 + p) * 16 + hi];
            k0o += c2.x * b2.x - c2.y * b2.y;
        }
#pragma unroll
        for (int kk = 0; kk < 16; ++kk) KT[(16 * kh + kk) * 256 + ho * 16 + hi] = ka[kk];
        if (kh == 0) K0[ho * 16 + hi] = k0o;
    }
    __syncthreads();
    bf16_t* By = BTY + (size_t)g * 512 * AGLD;
    for (int it = 0; it < 64; ++it) {
        const int pr = it * 16 + (tid >> 5), i = pr >> 5, jj = pr & 31, ho = (tid & 31) >> 1, half = tid & 1;
        const bool mine = dir == 0 ? (jj <= i) : (jj > i);
        if (mine) {
            const int k = dir == 0 ? (i - jj) : (jj - i);
            const LAS float* kp = KT + k * 256 + ho * 16 + 8 * half;
            f32x4 v0 = *(const LAS f32x4*)kp, v1 = *(const LAS f32x4*)(kp + 4);
            if (jj == i) { const LAS float* zp = K0 + ho * 16 + 8 * half; v0 = v0 + *(const LAS f32x4*)zp; v1 = v1 + *(const LAS f32x4*)(zp + 4); }
            u32x4 w; w.x = pk2(v0[0], v0[1]); w.y = pk2(v0[2], v0[3]); w.z = pk2(v1[0], v1[1]); w.w = pk2(v1[2], v1[3]);
            *(u32x4*)(By + (size_t)(i * 16 + ho) * AGLD + jj * 16 + 8 * half) = w;
        }
    }
    {
        const int i = tid >> 4, ho = tid & 15, e = dir == 0 ? (i + 1) : (32 - i);
        bf16_t* rowp = By + (size_t)tid * AGLD + 512 + 128 * dir;
        for (int p0 = 0; p0 < 64; p0 += 8) {
            float re[8], im[8];
#pragma unroll
            for (int q = 0; q < 8; ++q) { const f32x2 c = CC[(dir * 16 + ho) * 65 + p0 + q], w = PW[e * 64 + p0 + q]; re[q] = c.x * w.x - c.y * w.y; im[q] = -(c.x * w.y + c.y * w.x); }
            u32x4 wr_, wi_; wr_.x = pk2(re[0], re[1]); wr_.y = pk2(re[2], re[3]); wr_.z = pk2(re[4], re[5]); wr_.w = pk2(re[6], re[7]);
            wi_.x = pk2(im[0], im[1]); wi_.y = pk2(im[2], im[3]); wi_.z = pk2(im[4], im[5]); wi_.w = pk2(im[6], im[7]);
            *(u32x4*)(rowp + p0) = wr_; *(u32x4*)(rowp + 64 + p0) = wi_;
        }
    }
    {
        bf16_t* Bs = BTS + (size_t)g * 256 * 512;
        for (int it = 0; it < 8; ++it) {
            const int idx = it * NTHR + tid, half = idx & 1, jj = (idx >> 1) & 31, p = idx >> 6, e = dir == 0 ? (31 - jj) : jj;
            const f32x2 w = PW[e * 64 + p];
            float re[8], im[8];
#pragma unroll
            for (int q = 0; q < 8; ++q) { const f32x2 b = BB[(dir * 64 + p) * 16 + 8 * half + q]; re[q] = w.x * b.x - w.y * b.y; im[q] = w.x * b.y + w.y * b.x; }
            u32x4 wr_, wi_; wr_.x = pk2(re[0], re[1]); wr_.y = pk2(re[2], re[3]); wr_.z = pk2(re[4], re[5]); wr_.w = pk2(re[6], re[7]);
            wi_.x = pk2(im[0], im[1]); wi_.y = pk2(im[2], im[3]); wi_.z = pk2(im[4], im[5]); wi_.w = pk2(im[6], im[7]);
            *(u32x4*)(Bs + (size_t)(128 * dir + p) * 512 + jj * 16 + 8 * half) = wr_;
            *(u32x4*)(Bs + (size_t)(128 * dir + 64 + p) * 512 + jj * 16 + 8 * half) = wi_;
        }
    }
}

__device__ __forceinline__ void s5_carry_phase(const Args& a, int j, const float* SL, bf16_t* AG) {
    int tid = threadIdx.x; asm volatile("" : "+v"(tid));
    const int lane = tid & 63, wave = __builtin_amdgcn_readfirstlane(tid >> 6), G = gridDim.x, bx = blockIdx.x;
    const int gw = bx * NWAVES + wave, ngw = G * NWAVES, gtid = bx * NTHR + tid, ngt = G * NTHR; (void)lane; (void)gw; (void)ngw; (void)gtid; (void)ngt;
    for (int id = gtid; id < 128 * 8 * 2 * 64; id += ngt) {
        const int p = id & 63, dir = (id >> 6) & 1, b = (id >> 7) & 7, g = id >> 10;
        const size_t gi = ((size_t)(j * 2 + dir) * 128 + g) * 64 + p;
        const float ar = a.s5_are[gi], ai = a.s5_aim[gi];
        const float step = expf(a.s5_ls[(size_t)(j * 2 + dir) * 128 + g]);
        const float mag = expf(32.f * ar * step);
        float sn, cn; sincos_d(32.0 * (double)ai * (double)step, sn, cn);
        const float lr = mag * cn, li = mag * sn;
        float sr = 0.f, si = 0.f;
        const size_t row0 = (size_t)g * 1024 + b * 128;
        for (int c8 = 0; c8 < 128; c8 += 8) {
            float xr[8], xi[8];
#pragma unroll
            for (int q = 0; q < 8; ++q) { const int c = dir == 0 ? (c8 + q) : (127 - c8 - q); const float* s = SL + (row0 + c) * 256 + 128 * dir + p; xr[q] = s[0]; xi[q] = s[64]; }
#pragma unroll
            for (int q = 0; q < 8; ++q) { const int c = dir == 0 ? (c8 + q) : (127 - c8 - q); bf16_t* o = AG + (row0 + c) * AGLD + 512 + 128 * dir + p;
                o[0] = (bf16_t)f2bf(sr); o[64] = (bf16_t)f2bf(si);
                const float nr = lr * sr - li * si + xr[q], ni = lr * si + li * sr + xi[q]; sr = nr; si = ni; }
        }
    }
}

__device__ __forceinline__ void attn_phase(LAS unsigned char* lds, const bf16_t* Q, const bf16_t* Kb, const bf16_t* Vt, bf16_t* AO, const float* sink, const float* qg, const float* kg) {
    int tid = threadIdx.x; asm volatile("" : "+v"(tid));
    const int G = gridDim.x, cidx = blockIdx.x;
    const int wave = tid >> 6, lane = tid & 63, r = lane & 31, h = lane >> 5;
    constexpr int KROW = 144, VROW = 776;
    LAS unsigned char* Kl = lds; LAS unsigned char* Vl = lds + 384 * KROW;
    float gmq = fabsf(qg[lane]), gmk = fabsf(kg[lane]);
#pragma unroll
    for (int o = 1; o < 64; o <<= 1) { gmq = fmaxf(gmq, __shfl_xor(gmq, o)); gmk = fmaxf(gmk, __shfl_xor(gmk, o)); }
    const float MREF = fminf(11.5416f * 1.02f * gmq * gmk + 0.25f, 60.f);
    u32x4 kreg[6], vreg[6];
#define ATT_LOAD(uid_) do { const int kvh_ = (uid_) & 3, nb_ = ((uid_) >> 2) & 31, b_ = (uid_) >> 7; \
        _Pragma("unroll") for (int it = 0; it < 6; ++it) { const int idx = it * NTHR + tid, row = idx >> 3, ch = idx & 7, l = nb_ * 128 - 128 + row; kreg[it] = (u32x4){0u, 0u, 0u, 0u}; \
            if (l >= 0 && l < SEQ) kreg[it] = *(const u32x4*)(Kb + ((size_t)(b_ * SEQ + l)) * 256 + kvh_ * 64 + ch * 8); } \
        _Pragma("unroll") for (int it = 0; it < 6; ++it) { const int idx = it * NTHR + tid, d = idx / 48, ch = idx % 48, l = nb_ * 128 - 128 + ch * 8; vreg[it] = (u32x4){0u, 0u, 0u, 0u}; \
            if (l >= 0 && l < SEQ) vreg[it] = *(const u32x4*)(Vt + ((size_t)((b_ * 4 + kvh_) * 64 + d)) * SEQ + l); } } while (0)
    if (cidx < 1024) ATT_LOAD(cidx);
    for (int uid = cidx; uid < 1024; uid += G) {
        const int kvh = uid & 3, nb = (uid >> 2) & 31, b = uid >> 7;
        __syncthreads();
#pragma unroll
        for (int it = 0; it < 6; ++it) { const int idx = it * NTHR + tid, row = idx >> 3, ch = idx & 7; *(LAS u32x4*)(Kl + row * KROW + ch * 16) = kreg[it]; }
#pragma unroll
        for (int it = 0; it < 6; ++it) { const int idx = it * NTHR + tid, d = idx / 48, ch = idx % 48; LAS u32x2* pp = (LAS u32x2*)(Vl + d * VROW + ch * 16); pp[0] = (u32x2){vreg[it].x, vreg[it].y}; pp[1] = (u32x2){vreg[it].z, vreg[it].w}; }
        __syncthreads();
        if (uid + G < 1024) ATT_LOAD(uid + G);
        const int hq = kvh * 8 + wave;
        const float sk = sink[hq] * 1.44269504089f;
        const bf16_t* qbase = Q + (size_t)(b * SEQ + nb * 128 + r) * DM + hq * 64 + 8 * h;
        bf16x8 qf[4], qn[4];
#pragma unroll
        for (int s = 0; s < 4; ++s) qf[s] = *(const bf16x8*)(qbase + 16 * s);
        for (int sb = 0; sb < 4; ++sb) {
            const int q0 = sb * 32;
            if (sb < 3) {
#pragma unroll
                for (int s = 0; s < 4; ++s) qn[s] = *(const bf16x8*)(qbase + (size_t)(q0 + 32) * DM + 16 * s);
            }
            f32x16 o0, o1;
#pragma unroll
            for (int e = 0; e < 16; ++e) { o0[e] = 0.f; o1[e] = 0.f; }
            float lrun = (h == 0) ? __builtin_amdgcn_exp2f(sk - MREF) : 0.f;
            bf16x8 kf[4];
#pragma unroll
            for (int st = 0; st < 4; ++st) kf[st] = *(const LAS bf16x8*)(Kl + (q0 + r) * KROW + (16 * st + 8 * h) * 2);
            for (int cc = 0; cc < 9; ++cc) {
                const int kw0 = q0 + 32 * cc, l0 = nb * 128 - 128 + kw0;
                const bool valid = (l0 >= 0 && l0 < SEQ);
                u32x2 vv[2][2][2]; bf16x8 kn[4];
#pragma unroll
                for (int st = 0; st < 2; ++st)
#pragma unroll
                    for (int dt = 0; dt < 2; ++dt) { const LAS unsigned char* vp = Vl + (32 * dt + r) * VROW + (kw0 + 16 * st + 4 * h) * 2; vv[st][dt][0] = *(const LAS u32x2*)vp; vv[st][dt][1] = *(const LAS u32x2*)(vp + 16); }
                const int kwn = cc < 8 ? kw0 + 32 : kw0;
#pragma unroll
                for (int st = 0; st < 4; ++st) kn[st] = *(const LAS bf16x8*)(Kl + (kwn + r) * KROW + (16 * st + 8 * h) * 2);
                __builtin_amdgcn_sched_barrier(0);
                if (valid) {
                f32x16 sc;
#pragma unroll
                for (int e = 0; e < 16; ++e) sc[e] = -MREF;
#pragma unroll
                for (int st = 0; st < 4; ++st) sc = __builtin_amdgcn_mfma_f32_32x32x16_bf16(kf[st], qf[st], sc, 0, 0, 0);
                if (cc == 0) {
#pragma unroll
                    for (int e = 0; e < 16; ++e) { const int kj = (e & 3) + 8 * (e >> 2) + 4 * h; if (kj < r) sc[e] = -INFINITY; }
                }
                if (cc == 8) {
#pragma unroll
                    for (int e = 0; e < 16; ++e) { const int kj = (e & 3) + 8 * (e >> 2) + 4 * h; if (kj > r) sc[e] = -INFINITY; }
                }
                float ps = 0.f;
#pragma unroll
                for (int e = 0; e < 16; ++e) { const float pe = __builtin_amdgcn_exp2f(sc[e]); ps += pe; sc[e] = pe; }
                lrun += ps;
#pragma unroll
                for (int st = 0; st < 2; ++st) {
                    u32x4 pw; pw.x = cvt_pk_bf16(sc[8 * st + 0], sc[8 * st + 1]); pw.y = cvt_pk_bf16(sc[8 * st + 2], sc[8 * st + 3]); pw.z = cvt_pk_bf16(sc[8 * st + 4], sc[8 * st + 5]); pw.w = cvt_pk_bf16(sc[8 * st + 6], sc[8 * st + 7]);
                    const bf16x8 pf = __builtin_bit_cast(bf16x8, pw);
                    o0 = __builtin_amdgcn_mfma_f32_32x32x16_bf16(__builtin_bit_cast(bf16x8, (u32x4){vv[st][0][0].x, vv[st][0][0].y, vv[st][0][1].x, vv[st][0][1].y}), pf, o0, 0, 0, 0);
                    o1 = __builtin_amdgcn_mfma_f32_32x32x16_bf16(__builtin_bit_cast(bf16x8, (u32x4){vv[st][1][0].x, vv[st][1][0].y, vv[st][1][1].x, vv[st][1][1].y}), pf, o1, 0, 0, 0);
                }
                }
#pragma unroll
                for (int st = 0; st < 4; ++st) kf[st] = kn[st];
            }
            const float inv = 1.f / (lrun + __shfl_xor(lrun, 32));
            const int orow = b * SEQ + nb * 128 + q0 + r;
            bf16_t* op = AO + (((size_t)(orow >> 8) * 32 + hq) * 256 + (orow & 255)) * 64 + 4 * h;
#pragma unroll
            for (int rq = 0; rq < 4; ++rq) {
                u32x2 w0, w1; w0.x = cvt_pk_bf16(o0[4 * rq] * inv, o0[4 * rq + 1] * inv); w0.y = cvt_pk_bf16(o0[4 * rq + 2] * inv, o0[4 * rq + 3] * inv);
                w1.x = cvt_pk_bf16(o1[4 * rq] * inv, o1[4 * rq + 1] * inv); w1.y = cvt_pk_bf16(o1[4 * rq + 2] * inv, o1[4 * rq + 3] * inv);
                *(u32x2*)(op + 8 * rq) = w0; *(u32x2*)(op + 32 + 8 * rq) = w1;
            }
            if (sb < 3) {
#pragma unroll
                for (int s = 0; s < 4; ++s) qf[s] = qn[s];
            }
        }
    }
#undef ATT_LOAD
    __syncthreads();
}

#define XB_TMO      128
#define XB_XCNT(j)  (256  + 64 * (j))
#define XB_XSUB(j)  (1280 + 64 * (j))
#define XB_XGEN(j)  (2304 + 64 * (j))
#define XB_TOP      3328
#define XB_TOPGEN   3392
#define XCD_BAR_WORDS 3456
#define XB_SPIN_CAP (1u << 18)
__device__ __forceinline__ unsigned xb_ld(unsigned* p)              { return __hip_atomic_load(p, __ATOMIC_RELAXED, __HIP_MEMORY_SCOPE_AGENT); }
__device__ __forceinline__ unsigned xb_add(unsigned* p, unsigned v) { return __hip_atomic_fetch_add(p, v, __ATOMIC_RELAXED, __HIP_MEMORY_SCOPE_AGENT); }
__device__ __forceinline__ unsigned xb_xcc_id() { return (unsigned)__builtin_amdgcn_s_getreg((3 << 11) | 20) & 0xFu; }
#define XB_SPIN(cond, bar) do { unsigned _sp = 0; while (cond) { __builtin_amdgcn_s_sleep(1); \
    if ((++_sp & 255u) == 0u) { if (xb_ld(&(bar)[XB_TMO])) break; if (_sp > XB_SPIN_CAP) { atomicAdd(&(bar)[XB_TMO], 1u); break; } } } } while (0)
struct XcdBarrier { unsigned* bar; unsigned x; volatile LAS unsigned* st; };
__device__ __forceinline__ XcdBarrier xcd_barrier_post(unsigned* bar, volatile LAS unsigned* st) {
    XcdBarrier b; b.bar = bar; b.x = xb_xcc_id(); b.st = st;
    if (threadIdx.x == 0) (void)xb_add(&bar[XB_XCNT(b.x)], 1u);
    return b;
}
__device__ __forceinline__ void xcd_barrier_complete(unsigned* bar, unsigned x, unsigned& nloc, unsigned& nx) {
    const unsigned G = gridDim.x * gridDim.y * gridDim.z;
    unsigned sum, cnt, mine, sp = 0u;
    for (;;) {
        sum = 0u; cnt = 0u; mine = 0u;
#pragma unroll
        for (unsigned j = 0; j < 16; ++j) { const unsigned c = xb_ld(&bar[XB_XCNT(j)]); sum += c; cnt += (c > 0u) ? 1u : 0u; mine = (j == x) ? c : mine; }
        if (sum == G) break;
        __builtin_amdgcn_s_sleep(1);
        if ((++sp & 255u) == 0u) { if (xb_ld(&bar[XB_TMO])) break; if (sp > XB_SPIN_CAP) { atomicAdd(&bar[XB_TMO], 1u); break; } }
    }
    nloc = mine > 0u ? mine : 1u; nx = cnt > 0u ? cnt : 1u;
}
__device__ __forceinline__ void xcd_barrier(const XcdBarrier& b) {
    asm volatile("s_waitcnt vmcnt(0)" ::: "memory");
    __syncthreads();
    if (threadIdx.x == 0) {
        unsigned* bar = b.bar;
        __builtin_amdgcn_s_waitcnt(0);
        unsigned nloc = b.st[0], nx = b.st[1];
        if (nloc == 0u) { xcd_barrier_complete(bar, b.x, nloc, nx); b.st[0] = nloc; b.st[1] = nx; }
        const unsigned old = xb_add(&bar[XB_XSUB(b.x)], 1u);
        const unsigned gen = old / nloc;
        if (old + 1u == (gen + 1u) * nloc) {
            __builtin_amdgcn_fence(__ATOMIC_RELEASE, "agent");
            asm volatile("s_waitcnt vmcnt(0)" ::: "memory");
            const unsigned og = xb_add(&bar[XB_TOP], 1u);
            const unsigned tg = og / nx;
            if (og + 1u == (tg + 1u) * nx) xb_add(&bar[XB_TOPGEN], 1u);
            else XB_SPIN(xb_ld(&bar[XB_TOPGEN]) == tg, bar);
            __builtin_amdgcn_fence(__ATOMIC_ACQUIRE, "agent");
            xb_add(&bar[XB_XGEN(b.x)], 1u);
            asm volatile("s_waitcnt vmcnt(0)" ::: "memory");
        } else {
            XB_SPIN(xb_ld(&bar[XB_XGEN(b.x)]) == gen, bar);
            __builtin_amdgcn_fence(__ATOMIC_ACQUIRE, "agent");
            asm volatile("s_waitcnt vmcnt(0)" ::: "memory");
        }
    }
    __syncthreads();
}

__global__ void __launch_bounds__(NTHR, 2) fwd_kernel(Args a) {
    extern __shared__ __attribute__((aligned(16))) unsigned char lds_raw[];
    cg::grid_group grid = cg::this_grid();
    LAS unsigned char* lds = (LAS unsigned char*)lds_raw;
    const int G = gridDim.x, bx = blockIdx.x;
    volatile LAS unsigned* xst = (volatile LAS unsigned*)(lds + RS_OFF + 2048);
    if (threadIdx.x < 4) xst[threadIdx.x] = 0u;
    __syncthreads();
    const XcdBarrier xbar = xcd_barrier_post((unsigned*)a.ws, xst);
    bool first_seam = true;

    bf16_t* WUP = (bf16_t*)(a.ws + WS_WUP); bf16_t* WDN = (bf16_t*)(a.ws + WS_WDN); bf16_t* WGLU = (bf16_t*)(a.ws + WS_WGLU);
    bf16_t* WQKV = (bf16_t*)(a.ws + WS_WQKV); bf16_t* WO = (bf16_t*)(a.ws + WS_WO);
    float* CS = (float*)(a.ws + WS_CS); bf16_t* XN = (bf16_t*)(a.ws + WS_XN); bf16_t* HID = (bf16_t*)(a.ws + WS_HID);
    bf16_t* AG = (bf16_t*)(a.ws + WS_AG); bf16_t* BTY = (bf16_t*)(a.ws + WS_BTY); bf16_t* BTS = (bf16_t*)(a.ws + WS_BTS); float* SL = (float*)(a.ws + WS_SL);
    bf16_t* QB = (bf16_t*)(a.ws + WS_Q); bf16_t* KB = (bf16_t*)(a.ws + WS_KB); bf16_t* VT = (bf16_t*)(a.ws + WS_VT); bf16_t* AO = (bf16_t*)(a.ws + WS_AO);
    bf16_t* ZB = (bf16_t*)(a.ws + WS_Z); float* SS = (float*)(a.ws + WS_SS);

    for (int rep = 0; rep < REP_P0; ++rep) {
        convert_weights(a, lds);
        cs_phase(a.pos, CS);
    }

    for (int layer = 0; layer < 4; ++layer) {
        const int j = layer >> 1; const bool is_s5 = (layer & 1) == 0;
        if (is_s5) {
            for (int rep = 0; rep < REP_NORM; ++rep) norm_phase(layer == 0 ? a.x : nullptr, XN, XN, a.s5_norm + (size_t)j * DM, AG);
            for (int rep = 0; rep < REP_TAB; ++rep)
                for (int it = bx; it < 256; it += G) s5_tables_item(lds, a, j, it >> 1, it & 1, BTY, BTS);
            if (first_seam) { grid.sync(); first_seam = false; } else GSYNC();
            {   pg8::Gemm g{AG, BTS, AGLD, 512, 512, 0}; pg8::TileOrder S; S.init(512, 1, G, bx, 4);
                pg8::EpiS5S E{SL};
                for (int rep = 0; rep < REP_S5G; ++rep) pg8::gemm_phase<pg8::EpiS5S>(lds, g, S, E);
            }
            GSYNC();
            for (int rep = 0; rep < REP_CARRY; ++rep) s5_carry_phase(a, j, SL, AG);
            GSYNC();
            {   pg8::Gemm g{AG, BTY, AGLD, AGLD, AGLD, 0}; pg8::TileOrder S; S.init(512, 2, G, bx, 4);
                pg8::EpiS5Y E{AG, a.s5_d + (size_t)j * DM, ZB};
                for (int rep = 0; rep < REP_S5G; ++rep) pg8::gemm_phase<pg8::EpiS5Y>(lds, g, S, E);
            }
            GSYNC();
            {   pg8::Gemm g{ZB, WGLU + (size_t)j * 4096 * DM, DM, DM, DM, 0}; pg8::TileOrder S; S.init(128, 16, G, bx, 0);
                pg8::EpiGlu E{XN, SS + (size_t)layer * SS_USE};
                pg8::gemm_phase<pg8::EpiGlu>(lds, g, S, E);
            }
            GSYNC();
        } else {
            {   pg8::Gemm g{XN, WQKV + (size_t)j * NQKV * DM, DM, DM, DM, 0}; pg8::TileOrder S; S.init(128, 10, G, bx, 0);
                pg8::EpiQKV E{QB, KB, VT, a.at_qg + j * 64, a.at_kg + j * 64, CS, SS + (size_t)(4 + j) * SS_USE};
                for (int rep = 0; rep < REP_QKV; ++rep) pg8::gemm_phase<pg8::EpiQKV>(lds, g, S, E);
            }
            GSYNC();
            for (int rep = 0; rep < REP_ATTN; ++rep) attn_phase(lds, QB, KB, VT, AO, a.at_sink + j * 32, a.at_qg + j * 64, a.at_kg + j * 64);
            GSYNC();
            {   pg8::Gemm g{AO, WO + (size_t)j * DM * DM, DM, DM, DM, 1}; pg8::TileOrder S; S.init(128, 8, G, bx, 0);
                pg8::EpiResidual E{XN, SS + (size_t)layer * SS_USE, nullptr}; pg8::gemm_phase<pg8::EpiResidual>(lds, g, S, E); }
            GSYNC();
        }
        {   pg8::Gemm g{XN, WUP + (size_t)layer * DFF * DM, DM, DM, DM, 0}; pg8::TileOrder S; S.init(128, 32, G, bx, 0);
            pg8::EpiSqRelu E{HID, DFF, SS + (size_t)layer * SS_USE, is_s5 ? 64 : 32};
            for (int rep = 0; rep < REP_UP; ++rep) pg8::gemm_phase<pg8::EpiSqRelu>(lds, g, S, E);
        }
        GSYNC();
        {   pg8::Gemm g{HID, WDN + (size_t)layer * DM * DFF, DFF, DFF, DFF, 1}; pg8::TileOrder S; S.init(128, 8, G, bx, 0);
            pg8::EpiResidual E{XN, is_s5 ? SS + (size_t)(4 + j) * SS_USE : nullptr, layer == 3 ? a.out : nullptr}; pg8::gemm_phase<pg8::EpiResidual>(lds, g, S, E); }
        if (layer < 3) GSYNC();
    }
}

extern "C" void kernel_launch(void* const* d_in, const int* in_sizes, int n_in, void* d_out, int out_size, void* d_ws, size_t ws_size, hipStream_t stream) {
    static int grid = 0;
    if (grid == 0) {
        if (n_in != 22 || out_size != MTOK * DM || ws_size < WS_END2) { fprintf(stderr, "kernel_launch: unexpected sizes n_in %d out %d ws %zu\n", n_in, out_size, ws_size); grid = -1; return; }
        int dev = 0, cus = 0, per_cu = 0;
        hipGetDevice(&dev);
        hipDeviceGetAttribute(&cus, hipDeviceAttributeMultiprocessorCount, dev);
        if (hipFuncSetAttribute((const void*)fwd_kernel, hipFuncAttributeMaxDynamicSharedMemorySize, LDS_BYTES) != hipSuccess) { fprintf(stderr, "kernel_launch: hipFuncSetAttribute failed\n"); grid = -1; return; }
        if (hipOccupancyMaxActiveBlocksPerMultiprocessor(&per_cu, (const void*)fwd_kernel, NTHR, LDS_BYTES) != hipSuccess || per_cu < 1) { fprintf(stderr, "kernel_launch: occupancy query gives %d\n", per_cu); per_cu = 1; }
        (void)hipGetLastError();
        grid = cus * 1;
        if (grid <= 0) { grid = -1; return; }
    }
    if (grid < 0) return;
    Args a{};
    a.x = (const float*)d_in[0]; a.pos = (const int*)d_in[1];
    a.s5_norm = (const float*)d_in[2]; a.s5_are = (const float*)d_in[3]; a.s5_aim = (const float*)d_in[4]; a.s5_ls = (const float*)d_in[5];
    a.s5_bre = (const float*)d_in[6]; a.s5_bim = (const float*)d_in[7]; a.s5_cre = (const float*)d_in[8]; a.s5_cim = (const float*)d_in[9];
    a.s5_d = (const float*)d_in[10]; a.s5_wa = (const float*)d_in[11]; a.s5_wb = (const float*)d_in[12];
    a.at_norm = (const float*)d_in[13]; a.at_wqkv = (const float*)d_in[14]; a.at_qg = (const float*)d_in[15]; a.at_kg = (const float*)d_in[16];
    a.at_sink = (const float*)d_in[17]; a.at_wo = (const float*)d_in[18];
    a.ml_norm = (const float*)d_in[19]; a.ml_wup = (const float*)d_in[20]; a.ml_wdn = (const float*)d_in[21];
    a.out = (float*)d_out; a.ws = (unsigned char*)d_ws;
    if (hipMemsetAsync(d_ws, 0, 16384, stream) != hipSuccess) { fprintf(stderr, "kernel_launch: hipMemsetAsync failed\n"); return; }
    void* args[] = {&a};
    hipError_t e = hipLaunchCooperativeKernel((const void*)fwd_kernel, dim3(grid), dim3(NTHR), args, LDS_BYTES, stream);
    if (e != hipSuccess) fprintf(stderr, "kernel_launch: cooperative launch failed: %s (grid %d)\n", hipGetErrorString(e), grid);
}
```

```cpp
#include <hip/hip_runtime.h>
#include <hip/hip_cooperative_groups.h>
#include <cstdio>
#include <cstdint>
namespace cg = cooperative_groups;
#ifndef REP_P0
#define REP_P0 1
#endif
#ifndef REP_NORM
#define REP_NORM 1
#endif
#ifndef REP_TAB
#define REP_TAB 1
#endif
#ifndef REP_CARRY
#define REP_CARRY 1
#endif
#ifndef REP_S5G
#define REP_S5G 1
#endif
#ifndef REP_ATTN
#define REP_ATTN 1
#endif
#ifndef REP_QKV
#define REP_QKV 1
#endif
#ifndef REP_UP
#define REP_UP 1
#endif
#ifndef REP_SYNC
#define REP_SYNC 1
#endif
#define GSYNC() do { for (int _r = 0; _r < REP_SYNC; ++_r) xcd_barrier(xbar); } while (0)

#define LAS __attribute__((address_space(3)))
typedef unsigned short bf16_t;
typedef short bf16x8 __attribute__((ext_vector_type(8)));
typedef float f32x4 __attribute__((ext_vector_type(4)));
typedef float f32x2 __attribute__((ext_vector_type(2)));
typedef float f32x16 __attribute__((ext_vector_type(16)));
typedef unsigned u32x4 __attribute__((ext_vector_type(4)));
typedef unsigned u32x2 __attribute__((ext_vector_type(2)));
typedef unsigned long long u64;
constexpr size_t SS_USE = (size_t)64 * 32768;
constexpr int RS_OFF = 131072;

constexpr int BATCH = 8, SEQ = 4096, DM = 2048, MTOK = BATCH * SEQ, DFF = 8192, NQKV = 2560;
constexpr int S5T = 32;
constexpr int AGLD = 768;
constexpr int NWAVES = 8, NTHR = 512;
constexpr int LDS_BYTES = 147456;

constexpr size_t MiB = 1u << 20;
constexpr size_t WS_WUP = 1 * MiB, WS_WDN = 129 * MiB, WS_WGLU = 257 * MiB, WS_WQKV = 289 * MiB, WS_WO = 309 * MiB;
constexpr size_t WS_CS = 325 * MiB, WS_XN = 333 * MiB, WS_HID = 461 * MiB, WS_END = 973 * MiB;
constexpr size_t WS_AG = WS_HID, WS_BTY = WS_HID + 192 * MiB, WS_BTS = WS_HID + 288 * MiB, WS_SL = WS_HID + 320 * MiB;
constexpr size_t WS_Q = WS_HID, WS_KB = WS_HID + 128 * MiB, WS_VT = WS_HID + 144 * MiB, WS_AO = WS_HID + 160 * MiB;
constexpr size_t WS_Z = WS_SL;
constexpr size_t WS_SS = 973 * MiB;
constexpr size_t WS_END2 = 1021 * MiB;

__device__ __forceinline__ unsigned f2bf(float f) { unsigned u = __builtin_bit_cast(unsigned, f); return (u + 0x7fffu + ((u >> 16) & 1u)) >> 16; }
__device__ __forceinline__ unsigned pk2(float lo, float hi) { return f2bf(lo) | (f2bf(hi) << 16); }
__device__ __forceinline__ unsigned cvt_pk_bf16(float lo, float hi) { unsigned r; asm volatile("v_cvt_pk_bf16_f32 %0, %1, %2" : "=v"(r) : "v"(lo), "v"(hi)); return r; }
__device__ __forceinline__ float bf2f(unsigned b) { return __builtin_bit_cast(float, b << 16); }
__device__ __forceinline__ float wave_sum(float v) {
#pragma unroll
    for (int o = 1; o < 64; o <<= 1) v += __shfl_xor(v, o);
    return v;
}
__device__ __forceinline__ void sincos_d(double th, float& s, float& c) {
    double pio2 = 1.5707963267948966; asm volatile("" : "+s"(pio2));
    const float kf = rintf((float)th * 0.636619772f);
    const float t = (float)fma(-(double)kf, pio2, th);
    const float t2 = t * t;
    const float sp = t + t * t2 * (-1.6666654611e-1f + t2 * (8.3321608736e-3f + t2 * -1.9515295891e-4f));
    const float cp = 1.f - 0.5f * t2 + t2 * t2 * (4.166664568298827e-2f + t2 * (-1.388731625493765e-3f + t2 * 2.443315711809948e-5f));
    const int q = (int)kf & 3;
    s = (q == 0) ? sp : (q == 1) ? cp : (q == 2) ? -sp : -cp;
    c = (q == 0) ? cp : (q == 1) ? -sp : (q == 2) ? -cp : sp;
}

namespace pg8 {
constexpr int BM = 256, BK = 64, HALF = 128, HTB = HALF * BK * 2, STAGE_BYTES = 8 * HTB, NXCD = 8, WGM = 4;
__device__ __forceinline__ int lds_byte(int r, int c) { const int st = (r >> 4) * 2 + (c >> 5), rr = r & 15, cc = c & 31, ob = rr * 64 + cc * 2; return st * 1024 + (ob ^ (((ob >> 9) & 1) << 5)); }
__device__ __forceinline__ void stage_rc(int b, int& R, int& C) { const int st = b / 1024, sb = b % 1024, swz = sb ^ (((sb >> 9) & 1) << 5); R = (st >> 1) * 16 + swz / 64; C = (st & 1) * 32 + (swz % 64) / 2; }
__device__ __forceinline__ int perm32(int rho) { const int n = rho >> 4, i = rho & 15; return 8 * (i >> 2) + 4 * n + (i & 3); }

struct Unit { int pm, pn, pb; };
struct Gemm { const bf16_t* A; const bf16_t* Bt; int lda, ldb, K; int a_tiled; };

struct TileOrder {
    int nM, nN, nwg, G, c, bdiv;
    __device__ __forceinline__ void init(int nM_, int nN_, int G_, int c_, int bdiv_) { nM = nM_; nN = nN_; nwg = nM * nN; G = G_; c = c_; bdiv = bdiv_; }
    __device__ __forceinline__ bool next(int i, Unit& u) const {
        const long L = (long)i * G + c; if (L >= nwg) return false;
        int wgid = (int)L; { const int q = nwg / NXCD, r = nwg % NXCD, xcd = wgid % NXCD, off = wgid / NXCD; wgid = (xcd < r ? xcd * (q + 1) : r * (q + 1) + (xcd - r) * q) + off; }
        const int nig = WGM * nN, gid = wgid / nig, fm = gid * WGM, gsz = (nM - fm) < WGM ? (nM - fm) : WGM;
        u.pm = fm + ((wgid % nig) % gsz); u.pn = (wgid % nig) / gsz; u.pb = bdiv ? (u.pm / bdiv) * nN + u.pn : u.pn; return true;
    }
};

template <class Epi>
__device__ __forceinline__ void gemm_phase(LAS unsigned char* lds, const Gemm g, const TileOrder& S, const Epi& E) {
    int tid = threadIdx.x; asm volatile("" : "+v"(tid));
    const int wid = __builtin_amdgcn_readfirstlane(tid >> 6), lane = tid & 63, wr = wid >> 2, wc = wid & 3, fr = lane & 15, fq = lane >> 4;
    const int K = g.K, nt = K / BK;
    unsigned voffA[2], voffB[2];
#pragma unroll
    for (int i = 0; i < 2; ++i) { int R, C; stage_rc(tid * 16 + i * 8192, R, C); const int Rb = Epi::PERM ? ((R & ~31) + perm32(R & 31)) : R;
        voffA[i] = (unsigned)(R * (g.a_tiled ? 64 : g.lda) + C) * 2u; voffB[i] = (unsigned)(Rb * g.ldb + C) * 2u; }
    const size_t kstep = (size_t)(BK * 2);
    const size_t kstepA = g.a_tiled ? (size_t)32768 : kstep;
    const size_t hstepA = g.a_tiled ? (size_t)16384 : (size_t)HALF * g.lda * 2, tstepA = g.a_tiled ? (size_t)(g.K / 64) * 32768 : 2 * hstepA;
    const size_t hstepB = (size_t)HALF * g.ldb * 2, tstepB = 2 * hstepB;
    const unsigned ldsw = (unsigned)wid * 1024u;
    const int aoff = lds_byte(wr * 64 + fr, fq * 8), boff = lds_byte(wc * 32 + fr, fq * 8);
#define PG8_SA(b, h) (((b) * 2 + (h)) * HTB)
#define PG8_SB(b, h) ((4 + (b) * 2 + (h)) * HTB)
#define PG8_STAGE(bufoff, gbase, voff) do { _Pragma("unroll") for (int _i = 0; _i < 2; ++_i) \
        __builtin_amdgcn_global_load_lds((const unsigned*)((const char*)(gbase) + (voff)[_i]), (LAS unsigned*)(lds + (bufoff) + ldsw + _i * 8192), 16, 0, 0); } while (0)
#define PG8_LDA(dst, b, h) do { _Pragma("unroll") for (int m = 0; m < 4; ++m) _Pragma("unroll") for (int k = 0; k < 2; ++k) dst[m][k] = *(const LAS bf16x8*)(lds + PG8_SA(b, h) + aoff + m * 2048 + k * 1024); } while (0)
#define PG8_LDB(dst, b, h) do { _Pragma("unroll") for (int n = 0; n < 2; ++n) _Pragma("unroll") for (int k = 0; k < 2; ++k) dst[n][k] = *(const LAS bf16x8*)(lds + PG8_SB(b, h) + boff + n * 2048 + k * 1024); } while (0)
#define PG8_MMA(ai, bj, At, Bt) do { __builtin_amdgcn_s_setprio(1); _Pragma("unroll") for (int m = 0; m < 4; ++m) _Pragma("unroll") for (int n = 0; n < 2; ++n) _Pragma("unroll") for (int k = 0; k < 2; ++k) \
        acc[ai][bj][m][n] = __builtin_amdgcn_mfma_f32_16x16x32_bf16(Bt[n][k], At[m][k], acc[ai][bj][m][n], 0, 0, 0); __builtin_amdgcn_s_setprio(0); } while (0)
#define PG8_WAIT_V(n) asm volatile("s_waitcnt vmcnt(" #n ")" ::: "memory")
#define PG8_WAIT_L(n) asm volatile("s_waitcnt lgkmcnt(" #n ")" ::: "memory")
#define PG8_BAR __builtin_amdgcn_s_barrier()
#define PG8_SCHED __builtin_amdgcn_sched_barrier(0)
    Unit cur, nxt; int ui = 0; int estate = -1;
    if (!S.next(0, cur)) return;
    f32x4 acc[2][2][4][2];
#pragma unroll
    for (int a = 0; a < 2; ++a)
#pragma unroll
        for (int b = 0; b < 2; ++b)
#pragma unroll
            for (int m = 0; m < 4; ++m)
#pragma unroll
                for (int n = 0; n < 2; ++n) acc[a][b][m][n] = (f32x4){0.f, 0.f, 0.f, 0.f};
    bf16x8 At[4][2], B0[2][2], B1[2][2];
    const char* cA = (const char*)g.A + (size_t)cur.pm * tstepA; const char* cB = (const char*)g.Bt + (size_t)cur.pb * tstepB;
    PG8_STAGE(PG8_SB(0, 0), cB, voffB); PG8_STAGE(PG8_SB(0, 1), cB + hstepB, voffB); PG8_STAGE(PG8_SA(0, 0), cA, voffA); PG8_STAGE(PG8_SA(0, 1), cA + hstepA, voffA);
    if (wr == 1) PG8_BAR;
    PG8_WAIT_V(2); PG8_BAR;
    PG8_STAGE(PG8_SB(1, 0), cB + kstep, voffB); PG8_STAGE(PG8_SA(1, 0), cA + kstepA, voffA); PG8_STAGE(PG8_SB(1, 1), cB + hstepB + kstep, voffB);
    PG8_WAIT_V(6); PG8_BAR;
    for (;;) {
        const bool has_next = S.next(ui + 1, nxt);
        const char* nA = has_next ? (const char*)g.A + (size_t)nxt.pm * tstepA : cA; const char* nB = has_next ? (const char*)g.Bt + (size_t)nxt.pb * tstepB : cB;
        for (int t = 0; t < nt; t += 2) {
            const bool last = (t == nt - 2);
            const char* a1 = cA + (size_t)(t + 1) * kstepA;
            const char* a2 = last ? nA : cA + (size_t)(t + 2) * kstepA; const char* b2 = last ? nB : cB + (size_t)(t + 2) * kstep;
            const char* a3 = a2 + kstepA; const char* b3 = b2 + kstep;
            PG8_STAGE(PG8_SA(1, 1), a1 + hstepA, voffA); PG8_SCHED; PG8_LDB(B0, 0, 0); PG8_LDB(B1, 0, 1); PG8_SCHED; PG8_LDA(At, 0, 0);
            PG8_WAIT_V(8); PG8_WAIT_L(0); PG8_BAR; PG8_MMA(0, 0, At, B0); PG8_MMA(0, 1, At, B1); PG8_BAR; PG8_SCHED;
            PG8_STAGE(PG8_SB(0, 0), b2, voffB); PG8_STAGE(PG8_SB(0, 1), b2 + hstepB, voffB); PG8_STAGE(PG8_SA(0, 0), a2, voffA); PG8_SCHED; PG8_LDA(At, 0, 1);
            PG8_WAIT_V(8); PG8_WAIT_L(0); PG8_BAR; PG8_MMA(1, 0, At, B0); PG8_MMA(1, 1, At, B1); PG8_BAR; PG8_SCHED;
            PG8_STAGE(PG8_SA(0, 1), a2 + hstepA, voffA); PG8_SCHED; PG8_LDB(B0, 1, 0); PG8_LDB(B1, 1, 1); PG8_SCHED; PG8_LDA(At, 1, 0);
            PG8_WAIT_V(8); PG8_WAIT_L(0); PG8_BAR; PG8_MMA(0, 0, At, B0); PG8_MMA(0, 1, At, B1); PG8_BAR; PG8_SCHED;
            PG8_STAGE(PG8_SB(1, 0), b3, voffB); PG8_STAGE(PG8_SB(1, 1), b3 + hstepB, voffB); PG8_STAGE(PG8_SA(1, 0), a3, voffA); PG8_SCHED; PG8_LDA(At, 1, 1);
            PG8_WAIT_V(8); PG8_WAIT_L(0); PG8_BAR; PG8_MMA(1, 0, At, B0); PG8_MMA(1, 1, At, B1); PG8_BAR; PG8_SCHED;
        }
        if (wr == 0) PG8_BAR;
        E(acc, cur, wr, wc, fr, fq, lds, estate);
        if (!has_next) break;
#pragma unroll
        for (int a = 0; a < 2; ++a)
#pragma unroll
            for (int b = 0; b < 2; ++b)
#pragma unroll
                for (int m = 0; m < 4; ++m)
#pragma unroll
                    for (int n = 0; n < 2; ++n) acc[a][b][m][n] = (f32x4){0.f, 0.f, 0.f, 0.f};
        cur = nxt; cA = nA; cB = nB; ++ui;
        if (wr == 1) PG8_BAR;
    }
    PG8_WAIT_V(0);
    PG8_BAR;
#undef PG8_SA
#undef PG8_SB
#undef PG8_STAGE
#undef PG8_LDA
#undef PG8_LDB
#undef PG8_MMA
#undef PG8_WAIT_V
#undef PG8_WAIT_L
#undef PG8_BAR
#undef PG8_SCHED
}

__device__ __forceinline__ void panel_rstd(LAS unsigned char* lds, const float* ssp, int nslot, int pm, int& estate) {
    if (pm != estate) {
        estate = pm;
        int t = threadIdx.x; asm volatile("" : "+v"(t));
        const int row = t >> 1, half = t & 1, hs = nslot >> 1;
        const float* p = ssp + (size_t)(half * hs) * MTOK + pm * 256 + row;
        float v[16]; float sum = 0.f;
#pragma unroll
        for (int q = 0; q < 16; ++q) v[q] = p[(size_t)q * MTOK];
        __builtin_amdgcn_sched_barrier(0);
#pragma unroll
        for (int q = 0; q < 16; ++q) sum += v[q];
        if (hs == 32) {
            __builtin_amdgcn_sched_barrier(0);
#pragma unroll
            for (int q = 0; q < 16; ++q) v[q] = p[(size_t)(16 + q) * MTOK];
            __builtin_amdgcn_sched_barrier(0);
#pragma unroll
            for (int q = 0; q < 16; ++q) sum += v[q];
        }
        sum += __shfl_xor(sum, 1);
        if (half == 0) ((LAS float*)(lds + RS_OFF))[row] = __builtin_amdgcn_rsqf(sum * (1.f / DM) + 1e-6f);
        asm volatile("s_waitcnt lgkmcnt(0)" ::: "memory"); __builtin_amdgcn_s_barrier(); asm volatile("" ::: "memory");
    }
}

struct EpiSqRelu {
    static constexpr bool PERM = true;
    bf16_t* O; int ldc; const float* ssp; int nslot;
    __device__ __forceinline__ void operator()(const f32x4 (&acc)[2][2][4][2], const Unit& u, int wr, int wc, int fr, int fq, LAS unsigned char* lds, int& estate) const {
        asm volatile("" : "+v"(fr), "+v"(fq));
        const int row0 = u.pm * BM + wr * 64 + fr, col0 = u.pn * BM + wc * 32 + 8 * fq;
        panel_rstd(lds, ssp, nslot, u.pm, estate);
        float rs[2][4];
#pragma unroll
        for (int ai = 0; ai < 2; ++ai)
#pragma unroll
            for (int m = 0; m < 4; ++m) rs[ai][m] = ((const LAS float*)(lds + RS_OFF))[wr * 64 + fr + ai * HALF + m * 16];
#pragma unroll
        for (int ai = 0; ai < 2; ++ai)
#pragma unroll
            for (int m = 0; m < 4; ++m) {
                bf16_t* rowp = O + (((size_t)u.pm * (DFF / 64) + (u.pn * 4 + (wc >> 1))) * 256 + (wr * 64 + fr + ai * HALF + m * 16)) * 64 + (wc & 1) * 32 + 8 * fq;
                const float r_ = rs[ai][m];
#pragma unroll
                for (int bj = 0; bj < 2; ++bj) { f32x4 v0 = acc[ai][bj][m][0] * r_, v1 = acc[ai][bj][m][1] * r_;
                    v0 = __builtin_elementwise_max(v0, (f32x4){0.f, 0.f, 0.f, 0.f}); v1 = __builtin_elementwise_max(v1, (f32x4){0.f, 0.f, 0.f, 0.f});
                    v0 = v0 * v0; v1 = v1 * v1;
                    u32x4 w; w.x = cvt_pk_bf16(v0[0], v0[1]); w.y = cvt_pk_bf16(v0[2], v0[3]); w.z = cvt_pk_bf16(v1[0], v1[1]); w.w = cvt_pk_bf16(v1[2], v1[3]);
                    __builtin_nontemporal_store(w, (u32x4*)(rowp + (size_t)bj * 2 * 256 * 64)); } }
    }
};
struct EpiResidual {
    static constexpr bool PERM = true;
    bf16_t* HB; float* SS; float* OUT;
    __device__ __forceinline__ void operator()(const f32x4 (&acc)[2][2][4][2], const Unit& u, int wr, int wc, int fr, int fq, LAS unsigned char* lds, int& estate) const {
        asm volatile("" : "+v"(fr), "+v"(fq));
        const int row0 = u.pm * BM + wr * 64 + fr, col0 = u.pn * BM + wc * 32 + 8 * fq;
        u32x4 t[2][4][2];
#pragma unroll
        for (int ai = 0; ai < 2; ++ai)
#pragma unroll
            for (int m = 0; m < 4; ++m)
#pragma unroll
                for (int bj = 0; bj < 2; ++bj) t[ai][m][bj] = *(const u32x4*)(HB + (size_t)(row0 + ai * HALF + m * 16) * DM + col0 + bj * HALF);
#pragma unroll
        for (int ai = 0; ai < 2; ++ai)
#pragma unroll
            for (int m = 0; m < 4; ++m) {
                const size_t off = (size_t)(row0 + ai * HALF + m * 16) * DM + col0;
                float q = 0.f;
#pragma unroll
                for (int bj = 0; bj < 2; ++bj) {
                    const u32x4 w_ = t[ai][m][bj];
                    f32x4 o0 = acc[ai][bj][m][0], o1 = acc[ai][bj][m][1];
                    o0[0] += bf2f(w_.x & 0xffffu); o0[1] += bf2f(w_.x >> 16); o0[2] += bf2f(w_.y & 0xffffu); o0[3] += bf2f(w_.y >> 16);
                    o1[0] += bf2f(w_.z & 0xffffu); o1[1] += bf2f(w_.z >> 16); o1[2] += bf2f(w_.w & 0xffffu); o1[3] += bf2f(w_.w >> 16);
                    if (OUT) { *(f32x4*)(OUT + off + bj * HALF) = o0; *(f32x4*)(OUT + off + bj * HALF + 4) = o1; }
                    else { u32x4 w; w.x = cvt_pk_bf16(o0[0], o0[1]); w.y = cvt_pk_bf16(o0[2], o0[3]); w.z = cvt_pk_bf16(o1[0], o1[1]); w.w = cvt_pk_bf16(o1[2], o1[3]);
                        *(u32x4*)(HB + off + bj * HALF) = w; }
                    q += ((o0[0] * o0[0] + o0[1] * o0[1]) + (o0[2] * o0[2] + o0[3] * o0[3])) + ((o1[0] * o1[0] + o1[1] * o1[1]) + (o1[2] * o1[2] + o1[3] * o1[3])); }
                if (SS) { q += __shfl_xor(q, 16); q += __shfl_xor(q, 32); if (fq == 0) SS[(size_t)(u.pn * 4 + wc) * MTOK + row0 + ai * HALF + m * 16] = q; }
            }
        asm volatile("" ::: "memory");
    }
};
struct EpiGlu {
    static constexpr bool PERM = true;
    bf16_t* HB; float* SS;
    __device__ __forceinline__ void operator()(const f32x4 (&acc)[2][2][4][2], const Unit& u, int wr, int wc, int fr, int fq, LAS unsigned char* lds, int& estate) const {
        asm volatile("" : "+v"(fr), "+v"(fq));
        const int row0 = u.pm * BM + wr * 64 + fr, col0 = u.pn * HALF + wc * 32 + 8 * fq;
        u32x4 t[2][4];
#pragma unroll
        for (int ai = 0; ai < 2; ++ai)
#pragma unroll
            for (int m = 0; m < 4; ++m) t[ai][m] = *(const u32x4*)(HB + (size_t)(row0 + ai * HALF + m * 16) * DM + col0);
#pragma unroll
        for (int ai = 0; ai < 2; ++ai)
#pragma unroll
            for (int m = 0; m < 4; ++m) {
                const u32x4 w_ = t[ai][m];
                f32x4 o[2];
                o[0][0] = bf2f(w_.x & 0xffffu); o[0][1] = bf2f(w_.x >> 16); o[0][2] = bf2f(w_.y & 0xffffu); o[0][3] = bf2f(w_.y >> 16);
                o[1][0] = bf2f(w_.z & 0xffffu); o[1][1] = bf2f(w_.z >> 16); o[1][2] = bf2f(w_.w & 0xffffu); o[1][3] = bf2f(w_.w >> 16);
#pragma unroll
                for (int n = 0; n < 2; ++n) { const f32x4 av = acc[ai][0][m][n], bv = acc[ai][1][m][n];
#pragma unroll
                    for (int e = 0; e < 4; ++e) o[n][e] += av[e] * __builtin_amdgcn_rcpf(1.f + __expf(-bv[e])); }
                u32x4 w; w.x = cvt_pk_bf16(o[0][0], o[0][1]); w.y = cvt_pk_bf16(o[0][2], o[0][3]); w.z = cvt_pk_bf16(o[1][0], o[1][1]); w.w = cvt_pk_bf16(o[1][2], o[1][3]);
                *(u32x4*)(HB + (size_t)(row0 + ai * HALF + m * 16) * DM + col0) = w;
                float q = ((o[0][0] * o[0][0] + o[0][1] * o[0][1]) + (o[0][2] * o[0][2] + o[0][3] * o[0][3])) + ((o[1][0] * o[1][0] + o[1][1] * o[1][1]) + (o[1][2] * o[1][2] + o[1][3] * o[1][3]));
                q += __shfl_xor(q, 16); q += __shfl_xor(q, 32); if (fq == 0) SS[(size_t)(u.pn * 4 + wc) * MTOK + row0 + ai * HALF + m * 16] = q;
            }
        asm volatile("" ::: "memory");
    }
};
struct EpiQKV {
    static constexpr bool PERM = false;
    bf16_t *Q, *Kb, *Vt; const float *qg, *kg, *cs, *ssp;
    __device__ __forceinline__ void operator()(const f32x4 (&acc)[2][2][4][2], const Unit& u, int wr, int wc, int fr, int fq, LAS unsigned char* lds, int& estate) const {
        asm volatile("" : "+v"(fr), "+v"(fq));
        const int pn = u.pn, row0 = u.pm * BM + wr * 64 + fr;
        panel_rstd(lds, ssp, 32, u.pm, estate);
        const LAS float* rsb = (const LAS float*)(lds + RS_OFF) + wr * 64 + fr;
        if (pn < 9) {
            const float* gain = pn < 8 ? qg : kg;
            const float osc = pn < 8 ? 0.125f * 1.44269504089f : 1.f;
            f32x4 g1[2], g2[2];
#pragma unroll
            for (int n = 0; n < 2; ++n) { g1[n] = *(const f32x4*)(gain + 16 * n + 4 * fq); g2[n] = *(const f32x4*)(gain + 32 + 16 * n + 4 * fq); }
            f32x4 cb[2][2], sb[2][2];
#define QKV_LOADCS(buf_, g_) do { _Pragma("unroll") for (int n = 0; n < 2; ++n) { \
                const size_t off = (size_t)(row0 + ((g_) >> 2) * HALF + ((g_) & 3) * 16) * 32 + 16 * n + 4 * fq; \
                cb[buf_][n] = *(const f32x4*)(cs + off); sb[buf_][n] = *(const f32x4*)(cs + (size_t)MTOK * 32 + off); } } while (0)
            QKV_LOADCS(0, 0);
            __builtin_amdgcn_sched_barrier(0);
            float rsv[2][4];
#pragma unroll
            for (int ai = 0; ai < 2; ++ai)
#pragma unroll
                for (int m = 0; m < 4; ++m) {
                    float ss = 0.f;
#pragma unroll
                    for (int bj = 0; bj < 2; ++bj)
#pragma unroll
                        for (int n = 0; n < 2; ++n) { const f32x4 v = acc[ai][bj][m][n]; ss += (v[0] * v[0] + v[1] * v[1]) + (v[2] * v[2] + v[3] * v[3]); }
                    rsv[ai][m] = ss;
                }
#pragma unroll
            for (int ai = 0; ai < 2; ++ai)
#pragma unroll
                for (int m = 0; m < 4; ++m) rsv[ai][m] += __shfl_xor(rsv[ai][m], 16);
#pragma unroll
            for (int ai = 0; ai < 2; ++ai)
#pragma unroll
                for (int m = 0; m < 4; ++m) rsv[ai][m] += __shfl_xor(rsv[ai][m], 32);
#pragma unroll
            for (int ai = 0; ai < 2; ++ai)
#pragma unroll
                for (int m = 0; m < 4; ++m) { const float rr = rsb[ai * HALF + m * 16]; rsv[ai][m] = __builtin_amdgcn_rsqf(rsv[ai][m] * rr * rr * (1.f / 64.f) + 1e-6f) * rr * osc; }
#pragma unroll
            for (int gq = 0; gq < 8; ++gq) {
                const int ai = gq >> 2, m = gq & 3;
                if (gq < 7) QKV_LOADCS((gq + 1) & 1, gq + 1);
                const int row = row0 + ai * HALF + m * 16;
                const float rs = rsv[ai][m];
                bf16_t* dst = pn < 8 ? (Q + (size_t)row * DM + (4 * pn + wc) * 64) : (Kb + (size_t)row * 256 + wc * 64);
#pragma unroll
                for (int n = 0; n < 2; ++n) {
                    const f32x4 c4 = cb[gq & 1][n], s4 = sb[gq & 1][n];
                    const f32x4 x1 = acc[ai][0][m][n] * rs * g1[n], x2 = acc[ai][1][m][n] * rs * g2[n];
                    const f32x4 y1 = x1 * c4 - x2 * s4, y2 = x2 * c4 + x1 * s4;
                    u32x2 w1, w2; w1.x = cvt_pk_bf16(y1[0], y1[1]); w1.y = cvt_pk_bf16(y1[2], y1[3]); w2.x = cvt_pk_bf16(y2[0], y2[1]); w2.y = cvt_pk_bf16(y2[2], y2[3]);
                    *(u32x2*)(dst + 16 * n + 4 * fq) = w1; *(u32x2*)(dst + 32 + 16 * n + 4 * fq) = w2;
                }
                asm volatile("" ::: "memory");
            }
#undef QKV_LOADCS
        } else {
#pragma unroll
            for (int ai = 0; ai < 2; ++ai)
#pragma unroll
                for (int m = 0; m < 4; ++m) {
                    const int row = row0 + ai * HALF + m * 16, b = row >> 12, l = row & 4095;
                    const float rr = rsb[ai * HALF + m * 16];
                    bf16_t* base = Vt + ((size_t)(b * 4 + wc) * 64) * SEQ + l;
#pragma unroll
                    for (int bj = 0; bj < 2; ++bj)
#pragma unroll
                        for (int n = 0; n < 2; ++n)
#pragma unroll
                            for (int e = 0; e < 4; ++e) base[(size_t)(32 * bj + 16 * n + 4 * fq + e) * SEQ] = (bf16_t)f2bf(acc[ai][bj][m][n][e] * rr);
                }
        }
    }
};
struct EpiS5S {
    static constexpr bool PERM = false;
    float* SL;
    __device__ __forceinline__ void operator()(const f32x4 (&acc)[2][2][4][2], const Unit& u, int wr, int wc, int fr, int fq, LAS unsigned char* lds, int& estate) const {
        asm volatile("" : "+v"(fr), "+v"(fq));
        const int row0 = u.pm * BM + wr * 64 + fr, col0 = wc * 32 + 4 * fq;
#pragma unroll
        for (int ai = 0; ai < 2; ++ai)
#pragma unroll
            for (int m = 0; m < 4; ++m) { float* rowp = SL + (size_t)(row0 + ai * HALF + m * 16) * 256 + col0;
#pragma unroll
                for (int bj = 0; bj < 2; ++bj)
#pragma unroll
                    for (int n = 0; n < 2; ++n) *(f32x4*)(rowp + bj * HALF + n * 16) = acc[ai][bj][m][n]; }
    }
};
struct EpiS5Y {
    static constexpr bool PERM = true;
    const bf16_t* AG; const float* dsk; bf16_t* Z;
    __device__ __forceinline__ void operator()(const f32x4 (&acc)[2][2][4][2], const Unit& u, int wr, int wc, int fr, int fq, LAS unsigned char* lds, int& estate) const {
        asm volatile("" : "+v"(fr), "+v"(fq));
        const int row0 = u.pm * BM + wr * 64 + fr, col0 = u.pn * BM + wc * 32 + 8 * fq;
        const int g = (u.pm * BM) >> 10;
        u32x4 uw[2][4][2]; f32x4 dd[2][2];
#pragma unroll
        for (int ai = 0; ai < 2; ++ai)
#pragma unroll
            for (int m = 0; m < 4; ++m)
#pragma unroll
                for (int bj = 0; bj < 2; ++bj) uw[ai][m][bj] = *(const u32x4*)(AG + (size_t)(row0 + ai * HALF + m * 16) * AGLD + col0 + bj * HALF);
#pragma unroll
        for (int bj = 0; bj < 2; ++bj) { const int ch = 16 * g + ((col0 + bj * HALF) & 15); dd[bj][0] = *(const f32x4*)(dsk + ch); dd[bj][1] = *(const f32x4*)(dsk + ch + 4); }
#pragma unroll
        for (int ai = 0; ai < 2; ++ai)
#pragma unroll
            for (int m = 0; m < 4; ++m) {
                const int r = row0 + ai * HALF + m * 16, b = (r >> 7) & 7, c = r & 127;
#pragma unroll
                for (int bj = 0; bj < 2; ++bj) {
                    const int cc = col0 + bj * HALF, i = cc >> 4, ho = cc & 15, ch = 16 * g + ho;
                    const u32x4 w_ = uw[ai][m][bj]; const f32x4 d0 = dd[bj][0], d1 = dd[bj][1];
                    f32x4 v0 = acc[ai][bj][m][0], v1 = acc[ai][bj][m][1];
                    v0[0] += d0[0] * bf2f(w_.x & 0xffffu); v0[1] += d0[1] * bf2f(w_.x >> 16); v0[2] += d0[2] * bf2f(w_.y & 0xffffu); v0[3] += d0[3] * bf2f(w_.y >> 16);
                    v1[0] += d1[0] * bf2f(w_.z & 0xffffu); v1[1] += d1[1] * bf2f(w_.z >> 16); v1[2] += d1[2] * bf2f(w_.w & 0xffffu); v1[3] += d1[3] * bf2f(w_.w >> 16);
#pragma unroll
                    for (int e = 0; e < 4; ++e) {
                        const float a0 = v0[e], a1 = v1[e];
                        v0[e] = a0 * __builtin_amdgcn_rcpf(1.f + __expf(-1.5957691216057308f * (a0 + 0.044715f * a0 * a0 * a0)));
                        v1[e] = a1 * __builtin_amdgcn_rcpf(1.f + __expf(-1.5957691216057308f * (a1 + 0.044715f * a1 * a1 * a1)));
                    }
                    u32x4 w; w.x = cvt_pk_bf16(v0[0], v0[1]); w.y = cvt_pk_bf16(v0[2], v0[3]); w.z = cvt_pk_bf16(v1[0], v1[1]); w.w = cvt_pk_bf16(v1[2], v1[3]);
                    *(u32x4*)(Z + ((size_t)(b * SEQ + c * S5T + i)) * DM + ch) = w;
                }
            }
        asm volatile("" ::: "memory");
    }
};
}

__device__ __forceinline__ void transpose_item(const float* W, int N, bf16_t* WT, int K, int drow, int k0, int n0, LAS float* scr, int lane, const float* kgain = nullptr) {
    float wv[32];
#pragma unroll
    for (int i = 0; i < 32; ++i) { const int kk = 2 * i + (lane >> 5); wv[i] = W[(size_t)(k0 + kk) * N + n0 + (lane & 31)]; }
    if (kgain) {
#pragma unroll
        for (int i = 0; i < 32; ++i) wv[i] *= kgain[k0 + 2 * i + (lane >> 5)];
    }
#pragma unroll
    for (int i = 0; i < 32; ++i) scr[(2 * i + (lane >> 5)) * 33 + (lane & 31)] = wv[i];
    asm volatile("s_waitcnt lgkmcnt(0)" ::: "memory");
    const int c = lane & 7;
#pragma unroll
    for (int j = 0; j < 4; ++j) { const int n = (lane >> 3) + 8 * j; const LAS float* s = scr + (8 * c) * 33 + n;
        u32x4 o; o.x = pk2(s[0 * 33], s[1 * 33]); o.y = pk2(s[2 * 33], s[3 * 33]); o.z = pk2(s[4 * 33], s[5 * 33]); o.w = pk2(s[6 * 33], s[7 * 33]);
        *(u32x4*)(WT + (size_t)(drow + n) * K + k0 + 8 * c) = o; }
    asm volatile("s_waitcnt lgkmcnt(0)" ::: "memory");
}

struct Args {
    const float* x; const int* pos;
    const float *s5_norm, *s5_are, *s5_aim, *s5_ls, *s5_bre, *s5_bim, *s5_cre, *s5_cim, *s5_d, *s5_wa, *s5_wb;
    const float *at_norm, *at_wqkv, *at_qg, *at_kg, *at_sink, *at_wo;
    const float *ml_norm, *ml_wup, *ml_wdn;
    float* out; unsigned char* ws;
};

__device__ __forceinline__ void convert_weights(const Args& a, LAS unsigned char* lds) {
    int tid = threadIdx.x; asm volatile("" : "+v"(tid));
    const int lane = tid & 63, wave = __builtin_amdgcn_readfirstlane(tid >> 6), G = gridDim.x, bx = blockIdx.x;
    const int gw = bx * NWAVES + wave, ngw = G * NWAVES, gtid = bx * NTHR + tid, ngt = G * NTHR; (void)lane; (void)gw; (void)ngw; (void)gtid; (void)ngt;
    LAS float* scr = (LAS float*)(lds + wave * 16384);
    bf16_t* WUP = (bf16_t*)(a.ws + WS_WUP); bf16_t* WDN = (bf16_t*)(a.ws + WS_WDN); bf16_t* WGLU = (bf16_t*)(a.ws + WS_WGLU);
    bf16_t* WQKV = (bf16_t*)(a.ws + WS_WQKV); bf16_t* WO = (bf16_t*)(a.ws + WS_WO);
    constexpr int I_UP = 32 * 256, I_DN = 128 * 64, I_GL = 32 * 64, I_QKV = 32 * 80, I_WO = 32 * 64;
    constexpr int NITEMS = 4 * I_UP + 4 * I_DN + 4 * I_GL + 2 * I_QKV + 2 * I_WO;
    for (int it = gw; it < NITEMS; it += ngw) {
        int r = it;
        if (r < 4 * I_UP) { const int l = r / I_UP; r -= l * I_UP; const int kb = r / 256, nb = r % 256;
            transpose_item(a.ml_wup + (size_t)l * DM * DFF, DFF, WUP + (size_t)l * DFF * DM, DM, 32 * nb, 64 * kb, 32 * nb, scr, lane, a.ml_norm + (size_t)l * DM); continue; }
        r -= 4 * I_UP;
        if (r < 4 * I_DN) { const int l = r / I_DN; r -= l * I_DN; const int kb = r / 64, nb = r % 64;
            transpose_item(a.ml_wdn + (size_t)l * DFF * DM, DM, WDN + (size_t)l * DM * DFF, DFF, 32 * nb, 64 * kb, 32 * nb, scr, lane); continue; }
        r -= 4 * I_DN;
        if (r < 4 * I_GL) { const int q = r / I_GL; r -= q * I_GL; const int j = q >> 1, isb = q & 1; const int kb = r / 64, nb = r % 64, n0 = 32 * nb;
            const float* W = (isb ? a.s5_wb : a.s5_wa) + (size_t)j * DM * DM;
            transpose_item(W, DM, WGLU + (size_t)j * 4096 * DM, DM, (n0 >> 7) * 256 + isb * 128 + (n0 & 127), 64 * kb, n0, scr, lane); continue; }
        r -= 4 * I_GL;
        if (r < 2 * I_QKV) { const int j = r / I_QKV; r -= j * I_QKV; const int kb = r / 80, nb = r % 80, n0 = 32 * nb, head = n0 >> 6, dblk = (n0 >> 5) & 1;
            transpose_item(a.at_wqkv + (size_t)j * DM * NQKV, NQKV, WQKV + (size_t)j * NQKV * DM, DM, (head >> 2) * 256 + dblk * 128 + (head & 3) * 32, 64 * kb, n0, scr, lane, a.at_norm + (size_t)j * DM); continue; }
        r -= 2 * I_QKV;
        { const int j = r / I_WO; r -= j * I_WO; const int kb = r / 64, nb = r % 64;
            transpose_item(a.at_wo + (size_t)j * DM * DM, DM, WO + (size_t)j * DM * DM, DM, 32 * nb, 64 * kb, 32 * nb, scr, lane); }
    }
}

__device__ __forceinline__ void norm_phase(const float* srcf, const bf16_t* srcb, bf16_t* copy_dst, const float* gain, bf16_t* dst) {
    int tid = threadIdx.x; asm volatile("" : "+v"(tid));
    const int lane = tid & 63, wave = __builtin_amdgcn_readfirstlane(tid >> 6), G = gridDim.x, bx = blockIdx.x;
    const int gw = bx * NWAVES + wave, ngw = G * NWAVES;
    f32x4 gf[8], gb[8];
#pragma unroll
    for (int j = 0; j < 8; ++j) gf[j] = *(const f32x4*)(gain + 4 * lane + 256 * j);
#pragma unroll
    for (int j = 0; j < 4; ++j) { gb[2 * j] = *(const f32x4*)(gain + 8 * lane + 512 * j); gb[2 * j + 1] = *(const f32x4*)(gain + 8 * lane + 512 * j + 4); }
    for (int m = gw; m < MTOK; m += ngw) {
        const int b = m >> 12, l = m & 4095;
        if (srcf) {
            const f32x4* xr = (const f32x4*)(srcf + (size_t)m * DM) + lane;
            f32x4 v[8]; float ss = 0.f;
#pragma unroll
            for (int j = 0; j < 8; ++j) v[j] = xr[64 * j];
            __builtin_amdgcn_sched_barrier(0);
#pragma unroll
            for (int j = 0; j < 8; ++j) ss += (v[j][0] * v[j][0] + v[j][1] * v[j][1]) + (v[j][2] * v[j][2] + v[j][3] * v[j][3]);
            ss = wave_sum(ss);
            const float rstd = 1.0f / sqrtf(ss * (1.f / DM) + 1e-6f);
#pragma unroll
            for (int j = 0; j < 8; ++j) {
                const int col = 4 * lane + 256 * j;
                u32x2 c; c.x = pk2(v[j][0], v[j][1]); c.y = pk2(v[j][2], v[j][3]);
                *(u32x2*)(copy_dst + (size_t)m * DM + col) = c;
                const f32x4 o = v[j] * rstd * gf[j];
                u32x2 w; w.x = pk2(o[0], o[1]); w.y = pk2(o[2], o[3]);
                const int gg = col >> 4, hh = col & 15; *(u32x2*)(dst + ((size_t)(gg * 1024 + b * 128 + (l >> 5))) * AGLD + (l & 31) * 16 + hh) = w;
            }
        } else {
            const u32x4* xr = (const u32x4*)(srcb + (size_t)m * DM) + lane;
            float v[4][8]; float ss = 0.f; u32x4 wl[4];
#pragma unroll
            for (int j = 0; j < 4; ++j) wl[j] = xr[64 * j];
            __builtin_amdgcn_sched_barrier(0);
#pragma unroll
            for (int j = 0; j < 4; ++j) { const u32x4 w_ = wl[j];
                v[j][0] = bf2f(w_.x & 0xffffu); v[j][1] = bf2f(w_.x >> 16); v[j][2] = bf2f(w_.y & 0xffffu); v[j][3] = bf2f(w_.y >> 16);
                v[j][4] = bf2f(w_.z & 0xffffu); v[j][5] = bf2f(w_.z >> 16); v[j][6] = bf2f(w_.w & 0xffffu); v[j][7] = bf2f(w_.w >> 16);
#pragma unroll
                for (int e = 0; e < 8; ++e) ss += v[j][e] * v[j][e]; }
            ss = wave_sum(ss);
            const float rstd = 1.0f / sqrtf(ss * (1.f / DM) + 1e-6f);
#pragma unroll
            for (int j = 0; j < 4; ++j) {
                const int col = 8 * lane + 512 * j;
                const f32x4 g0 = gb[2 * j], g1 = gb[2 * j + 1];
                u32x4 w; w.x = pk2(v[j][0] * rstd * g0[0], v[j][1] * rstd * g0[1]); w.y = pk2(v[j][2] * rstd * g0[2], v[j][3] * rstd * g0[3]);
                w.z = pk2(v[j][4] * rstd * g1[0], v[j][5] * rstd * g1[1]); w.w = pk2(v[j][6] * rstd * g1[2], v[j][7] * rstd * g1[3]);
                const int gg = col >> 4, hh = col & 15; *(u32x4*)(dst + ((size_t)(gg * 1024 + b * 128 + (l >> 5))) * AGLD + (l & 31) * 16 + hh) = w;
            }
        }
    }
}

__device__ __forceinline__ void cs_phase(const int* pos, float* cs) {
    int tid = threadIdx.x; asm volatile("" : "+v"(tid));
    const int lane = tid & 63, wave = __builtin_amdgcn_readfirstlane(tid >> 6), G = gridDim.x, bx = blockIdx.x;
    const int gw = bx * NWAVES + wave, ngw = G * NWAVES, gtid = bx * NTHR + tid, ngt = G * NTHR; (void)lane; (void)gw; (void)ngw; (void)gtid; (void)ngt;
    for (int idx = gtid; idx < MTOK * 32; idx += ngt) {
        const int m = idx >> 5, j = idx & 31;
        const double inv = (double)exp2f(-(float)j * (13.287712379549449f / 32.0f));
        float s, c; sincos_d((double)pos[m] * inv, s, c);
        cs[idx] = c; cs[(size_t)MTOK * 32 + idx] = s;
    }
}

__device__ __forceinline__ void s5_tables_item(LAS unsigned char* lds, const Args& a, int j, int g, int dir, bf16_t* BTY, bf16_t* BTS) {
    int tid = threadIdx.x; asm volatile("" : "+v"(tid));
    LAS f32x2* LAM = (LAS f32x2*)lds;
    LAS f32x2* FF = LAM + 128;
    LAS f32x2* BB = FF + 128;
    LAS f32x2* CC = BB + 2048;
    LAS f32x2* PW = CC + 2080;
    LAS float* KT = (LAS float*)(PW + 2112);
    LAS float* K0 = KT + 8192;
    __syncthreads();
    if (tid < 128) {
        const int d = tid >> 6, p = tid & 63;
        const size_t gi = ((size_t)(j * 2 + d) * 128 + g) * 64 + p;
        const float ar = a.s5_are[gi], ai = a.s5_aim[gi];
        const float step = expf(a.s5_ls[(size_t)(j * 2 + d) * 128 + g]);
        const float mag = expf(ar * step);
        float sn, cn; sincos_d((double)ai * (double)step, sn, cn);
        const float lre = mag * cn, lim = mag * sn;
        const float den = ar * ar + ai * ai, nr = lre - 1.f, ni = lim;
        LAM[tid] = (f32x2){lre, lim};
        FF[tid] = (f32x2){(nr * ar + ni * ai) / den, (ni * ar - nr * ai) / den};
    }
    for (int idx = tid; idx < 33 * 64; idx += NTHR) {
        const int k = idx >> 6, p = idx & 63;
        const size_t gi = ((size_t)(j * 2 + dir) * 128 + g) * 64 + p;
        const float ar = a.s5_are[gi], ai = a.s5_aim[gi];
        const float step = expf(a.s5_ls[(size_t)(j * 2 + dir) * 128 + g]);
        const float mag = expf((float)k * ar * step);
        float sn, cn; sincos_d((double)k * (double)ai * (double)step, sn, cn);
        PW[idx] = (f32x2){mag * cn, mag * sn};
    }
    __syncthreads();
    for (int idx = tid; idx < 2048; idx += NTHR) {
        const int d = idx >> 10, p = (idx >> 4) & 63, h = idx & 15;
        const size_t gi = (((size_t)(j * 2 + d) * 128 + g) * 64 + p) * 16 + h;
        const float br = a.s5_bre[gi], bi = a.s5_bim[gi];
        const f32x2 f = FF[d * 64 + p];
        BB[idx] = (f32x2){f.x * br - f.y * bi, f.x * bi + f.y * br};
    }
    for (int idx = tid; idx < 2048; idx += NTHR) {
        const int d = idx >> 10, h = (idx >> 6) & 15, p = idx & 63;
        const size_t gi = (((size_t)(j * 2 + d) * 128 + g) * 16 + h) * 64 + p;
        CC[(d * 16 + h) * 65 + p] = (f32x2){a.s5_cre[gi], a.s5_cim[gi]};
    }
    __syncthreads();
    {
        const int kh = tid >> 8, ho = (tid >> 4) & 15, hi = tid & 15;
        float ka[16]; float k0o = 0.f;
#pragma unroll
        for (int kk = 0; kk < 16; ++kk) ka[kk] = 0.f;
        for (int p = 0; p < 64; ++p) {
            const f32x2 c = CC[(dir * 16 + ho) * 65 + p], b = BB[(dir * 64 + p) * 16 + hi];
            const float cbr = c.x * b.x - c.y * b.y, cbi = c.x * b.y + c.y * b.x;
#pragma unroll
            for (int kk = 0; kk < 16; ++kk) { const f32x2 w = PW[(16 * kh + kk) * 64 + p]; ka[kk] += cbr * w.x - cbi * w.y; }
            const f32x2 c2 = CC[((1 - dir) * 16 + ho) * 65 + p], b2 = BB[((1 - dir) * 64 + p) * 16 + hi];
            k0o += c2.x * b2.x - c2.y * b2.y;
        }
#pragma unroll
        for (int kk = 0; kk < 16; ++kk) KT[(16 * kh + kk) * 256 + ho * 16 + hi] = ka[kk];
        if (kh == 0) K0[ho * 16 + hi] = k0o;
    }
    __syncthreads();
    bf16_t* By = BTY + (size_t)g * 512 * AGLD;
    for (int it = 0; it < 64; ++it) {
        const int pr = it * 16 + (tid >> 5), i = pr >> 5, jj = pr & 31, ho = (tid & 31) >> 1, half = tid & 1;
        const bool mine = dir == 0 ? (jj <= i) : (jj > i);
        if (mine) {
            const int k = dir == 0 ? (i - jj) : (jj - i);
            const LAS float* kp = KT + k * 256 + ho * 16 + 8 * half;
            f32x4 v0 = *(const LAS f32x4*)kp, v1 = *(const LAS f32x4*)(kp + 4);
            if (jj == i) { const LAS float* zp = K0 + ho * 16 + 8 * half; v0 = v0 + *(const LAS f32x4*)zp; v1 = v1 + *(const LAS f32x4*)(zp + 4); }
            u32x4 w; w.x = pk2(v0[0], v0[1]); w.y = pk2(v0[2], v0[3]); w.z = pk2(v1[0], v1[1]); w.w = pk2(v1[2], v1[3]);
            *(u32x4*)(By + (size_t)(i * 16 + ho) * AGLD + jj * 16 + 8 * half) = w;
        }
    }
    {
        const int i = tid >> 4, ho = tid & 15, e = dir == 0 ? (i + 1) : (32 - i);
        bf16_t* rowp = By + (size_t)tid * AGLD + 512 + 128 * dir;
        for (int p0 = 0; p0 < 64; p0 += 8) {
            float re[8], im[8];
#pragma unroll
            for (int q = 0; q < 8; ++q) { const f32x2 c = CC[(dir * 16 + ho) * 65 + p0 + q], w = PW[e * 64 + p0 + q]; re[q] = c.x * w.x - c.y * w.y; im[q] = -(c.x * w.y + c.y * w.x); }
            u32x4 wr_, wi_; wr_.x = pk2(re[0], re[1]); wr_.y = pk2(re[2], re[3]); wr_.z = pk2(re[4], re[5]); wr_.w = pk2(re[6], re[7]);
            wi_.x = pk2(im[0], im[1]); wi_.y = pk2(im[2], im[3]); wi_.z = pk2(im[4], im[5]); wi_.w = pk2(im[6], im[7]);
            *(u32x4*)(rowp + p0) = wr_; *(u32x4*)(rowp + 64 + p0) = wi_;
        }
    }
    {
        bf16_t* Bs = BTS + (size_t)g * 256 * 512;
        for (int it = 0; it < 8; ++it) {
            const int idx = it * NTHR + tid, half = idx & 1, jj = (idx >> 1) & 31, p = idx >> 6, e = dir == 0 ? (31 - jj) : jj;
            const f32x2 w = PW[e * 64 + p];
            float re[8], im[8];
#pragma unroll
            for (int q = 0; q < 8; ++q) { const f32x2 b = BB[(dir * 64 + p) * 16 + 8 * half + q]; re[q] = w.x * b.x - w.y * b.y; im[q] = w.x * b.y + w.y * b.x; }
            u32x4 wr_, wi_; wr_.x = pk2(re[0], re[1]); wr_.y = pk2(re[2], re[3]); wr_.z = pk2(re[4], re[5]); wr_.w = pk2(re[6], re[7]);
            wi_.x = pk2(im[0], im[1]); wi_.y = pk2(im[2], im[3]); wi_.z = pk2(im[4], im[5]); wi_.w = pk2(im[6], im[7]);
            *(u32x4*)(Bs + (size_t)(128 * dir + p) * 512 + jj * 16 + 8 * half) = wr_;
            *(u32x4*)(Bs + (size_t)(128 * dir + 64 + p) * 512 + jj * 16 + 8 * half) = wi_;
        }
    }
}

__device__ __forceinline__ void s5_carry_phase(const Args& a, int j, const float* SL, bf16_t* AG) {
    int tid = threadIdx.x; asm volatile("" : "+v"(tid));
    const int lane = tid & 63, wave = __builtin_amdgcn_readfirstlane(tid >> 6), G = gridDim.x, bx = blockIdx.x;
    const int gw = bx * NWAVES + wave, ngw = G * NWAVES, gtid = bx * NTHR + tid, ngt = G * NTHR; (void)lane; (void)gw; (void)ngw; (void)gtid; (void)ngt;
    for (int id = gtid; id < 128 * 8 * 2 * 64; id += ngt) {
        const int p = id & 63, dir = (id >> 6) & 1, b = (id >> 7) & 7, g = id >> 10;
        const size_t gi = ((size_t)(j * 2 + dir) * 128 + g) * 64 + p;
        const float ar = a.s5_are[gi], ai = a.s5_aim[gi];
        const float step = expf(a.s5_ls[(size_t)(j * 2 + dir) * 128 + g]);
        const float mag = expf(32.f * ar * step);
        float sn, cn; sincos_d(32.0 * (double)ai * (double)step, sn, cn);
        const float lr = mag * cn, li = mag * sn;
        float sr = 0.f, si = 0.f;
        const size_t row0 = (size_t)g * 1024 + b * 128;
        for (int c8 = 0; c8 < 128; c8 += 8) {
            float xr[8], xi[8];
#pragma unroll
            for (int q = 0; q < 8; ++q) { const int c = dir == 0 ? (c8 + q) : (127 - c8 - q); const float* s = SL + (row0 + c) * 256 + 128 * dir + p; xr[q] = s[0]; xi[q] = s[64]; }
#pragma unroll
            for (int q = 0; q < 8; ++q) { const int c = dir == 0 ? (c8 + q) : (127 - c8 - q); bf16_t* o = AG + (row0 + c) * AGLD + 512 + 128 * dir + p;
                o[0] = (bf16_t)f2bf(sr); o[64] = (bf16_t)f2bf(si);
                const float nr = lr * sr - li * si + xr[q], ni = lr * si + li * sr + xi[q]; sr = nr; si = ni; }
        }
    }
}

__device__ __forceinline__ void attn_phase(LAS unsigned char* lds, const bf16_t* Q, const bf16_t* Kb, const bf16_t* Vt, bf16_t* AO, const float* sink, const float* qg, const float* kg) {
    int tid = threadIdx.x; asm volatile("" : "+v"(tid));
    const int G = gridDim.x, cidx = blockIdx.x;
    const int wave = tid >> 6, lane = tid & 63, r = lane & 31, h = lane >> 5;
    constexpr int KROW = 144, VROW = 776;
    LAS unsigned char* Kl = lds; LAS unsigned char* Vl = lds + 384 * KROW;
    float gmq = fabsf(qg[lane]), gmk = fabsf(kg[lane]);
#pragma unroll
    for (int o = 1; o < 64; o <<= 1) { gmq = fmaxf(gmq, __shfl_xor(gmq, o)); gmk = fmaxf(gmk, __shfl_xor(gmk, o)); }
    const float MREF = fminf(11.5416f * 1.02f * gmq * gmk + 0.25f, 60.f);
    u32x4 kreg[6], vreg[6];
#define ATT_LOAD(uid_) do { const int kvh_ = (uid_) & 3, nb_ = ((uid_) >> 2) & 31, b_ = (uid_) >> 7; \
        _Pragma("unroll") for (int it = 0; it < 6; ++it) { const int idx = it * NTHR + tid, row = idx >> 3, ch = idx & 7, l = nb_ * 128 - 128 + row; kreg[it] = (u32x4){0u, 0u, 0u, 0u}; \
            if (l >= 0 && l < SEQ) kreg[it] = *(const u32x4*)(Kb + ((size_t)(b_ * SEQ + l)) * 256 + kvh_ * 64 + ch * 8); } \
        _Pragma("unroll") for (int it = 0; it < 6; ++it) { const int idx = it * NTHR + tid, d = idx / 48, ch = idx % 48, l = nb_ * 128 - 128 + ch * 8; vreg[it] = (u32x4){0u, 0u, 0u, 0u}; \
            if (l >= 0 && l < SEQ) vreg[it] = *(const u32x4*)(Vt + ((size_t)((b_ * 4 + kvh_) * 64 + d)) * SEQ + l); } } while (0)
    if (cidx < 1024) ATT_LOAD(cidx);
    for (int uid = cidx; uid < 1024; uid += G) {
        const int kvh = uid & 3, nb = (uid >> 2) & 31, b = uid >> 7;
        __syncthreads();
#pragma unroll
        for (int it = 0; it < 6; ++it) { const int idx = it * NTHR + tid, row = idx >> 3, ch = idx & 7; *(LAS u32x4*)(Kl + row * KROW + ch * 16) = kreg[it]; }
#pragma unroll
        for (int it = 0; it < 6; ++it) { const int idx = it * NTHR + tid, d = idx / 48, ch = idx % 48; LAS u32x2* pp = (LAS u32x2*)(Vl + d * VROW + ch * 16); pp[0] = (u32x2){vreg[it].x, vreg[it].y}; pp[1] = (u32x2){vreg[it].z, vreg[it].w}; }
        __syncthreads();
        if (uid + G < 1024) ATT_LOAD(uid + G);
        const int hq = kvh * 8 + wave;
        const float sk = sink[hq] * 1.44269504089f;
        const bf16_t* qbase = Q + (size_t)(b * SEQ + nb * 128 + r) * DM + hq * 64 + 8 * h;
        bf16x8 qf[4], qn[4];
#pragma unroll
        for (int s = 0; s < 4; ++s) qf[s] = *(const bf16x8*)(qbase + 16 * s);
        for (int sb = 0; sb < 4; ++sb) {
            const int q0 = sb * 32;
            if (sb < 3) {
#pragma unroll
                for (int s = 0; s < 4; ++s) qn[s] = *(const bf16x8*)(qbase + (size_t)(q0 + 32) * DM + 16 * s);
            }
            f32x16 o0, o1;
#pragma unroll
            for (int e = 0; e < 16; ++e) { o0[e] = 0.f; o1[e] = 0.f; }
            float lrun = (h == 0) ? __builtin_amdgcn_exp2f(sk - MREF) : 0.f;
            bf16x8 kf[4];
#pragma unroll
            for (int st = 0; st < 4; ++st) kf[st] = *(const LAS bf16x8*)(Kl + (q0 + r) * KROW + (16 * st + 8 * h) * 2);
            for (int cc = 0; cc < 9; ++cc) {
                const int kw0 = q0 + 32 * cc, l0 = nb * 128 - 128 + kw0;
                const bool valid = (l0 >= 0 && l0 < SEQ);
                u32x2 vv[2][2][2]; bf16x8 kn[4];
#pragma unroll
                for (int st = 0; st < 2; ++st)
#pragma unroll
                    for (int dt = 0; dt < 2; ++dt) { const LAS unsigned char* vp = Vl + (32 * dt + r) * VROW + (kw0 + 16 * st + 4 * h) * 2; vv[st][dt][0] = *(const LAS u32x2*)vp; vv[st][dt][1] = *(const LAS u32x2*)(vp + 16); }
                const int kwn = cc < 8 ? kw0 + 32 : kw0;
#pragma unroll
                for (int st = 0; st < 4; ++st) kn[st] = *(const LAS bf16x8*)(Kl + (kwn + r) * KROW + (16 * st + 8 * h) * 2);
                __builtin_amdgcn_sched_barrier(0);
                if (valid) {
                f32x16 sc;
#pragma unroll
                for (int e = 0; e < 16; ++e) sc[e] = -MREF;
#pragma unroll
                for (int st = 0; st < 4; ++st) sc = __builtin_amdgcn_mfma_f32_32x32x16_bf16(kf[st], qf[st], sc, 0, 0, 0);
                if (cc == 0) {
#pragma unroll
                    for (int e = 0; e < 16; ++e) { const int kj = (e & 3) + 8 * (e >> 2) + 4 * h; if (kj < r) sc[e] = -INFINITY; }
                }
                if (cc == 8) {
#pragma unroll
                    for (int e = 0; e < 16; ++e) { const int kj = (e & 3) + 8 * (e >> 2) + 4 * h; if (kj > r) sc[e] = -INFINITY; }
                }
                float ps = 0.f;
#pragma unroll
                for (int e = 0; e < 16; ++e) { const float pe = __builtin_amdgcn_exp2f(sc[e]); ps += pe; sc[e] = pe; }
                lrun += ps;
#pragma unroll
                for (int st = 0; st < 2; ++st) {
                    u32x4 pw; pw.x = cvt_pk_bf16(sc[8 * st + 0], sc[8 * st + 1]); pw.y = cvt_pk_bf16(sc[8 * st + 2], sc[8 * st + 3]); pw.z = cvt_pk_bf16(sc[8 * st + 4], sc[8 * st + 5]); pw.w = cvt_pk_bf16(sc[8 * st + 6], sc[8 * st + 7]);
                    const bf16x8 pf = __builtin_bit_cast(bf16x8, pw);
                    o0 = __builtin_amdgcn_mfma_f32_32x32x16_bf16(__builtin_bit_cast(bf16x8, (u32x4){vv[st][0][0].x, vv[st][0][0].y, vv[st][0][1].x, vv[st][0][1].y}), pf, o0, 0, 0, 0);
                    o1 = __builtin_amdgcn_mfma_f32_32x32x16_bf16(__builtin_bit_cast(bf16x8, (u32x4){vv[st][1][0].x, vv[st][1][0].y, vv[st][1][1].x, vv[st][1][1].y}), pf, o1, 0, 0, 0);
                }
                }
#pragma unroll
                for (int st = 0; st < 4; ++st) kf[st] = kn[st];
            }
            const float inv = 1.f / (lrun + __shfl_xor(lrun, 32));
            const int orow = b * SEQ + nb * 128 + q0 + r;
            bf16_t* op = AO + (((size_t)(orow >> 8) * 32 + hq) * 256 + (orow & 255)) * 64 + 4 * h;
#pragma unroll
            for (int rq = 0; rq < 4; ++rq) {
                u32x2 w0, w1; w0.x = cvt_pk_bf16(o0[4 * rq] * inv, o0[4 * rq + 1] * inv); w0.y = cvt_pk_bf16(o0[4 * rq + 2] * inv, o0[4 * rq + 3] * inv);
                w1.x = cvt_pk_bf16(o1[4 * rq] * inv, o1[4 * rq + 1] * inv); w1.y = cvt_pk_bf16(o1[4 * rq + 2] * inv, o1[4 * rq + 3] * inv);
                *(u32x2*)(op + 8 * rq) = w0; *(u32x2*)(op + 32 + 8 * rq) = w1;
            }
            if (sb < 3) {
#pragma unroll
                for (int s = 0; s < 4; ++s) qf[s] = qn[s];
            }
        }
    }
#undef ATT_LOAD
    __syncthreads();
}

#define XB_TMO      128
#define XB_XCNT(j)  (256  + 64 * (j))
#define XB_XSUB(j)  (1280 + 64 * (j))
#define XB_XGEN(j)  (2304 + 64 * (j))
#define XB_TOP      3328
#define XB_TOPGEN   3392
#define XCD_BAR_WORDS 3456
#define XB_SPIN_CAP (1u << 18)
__device__ __forceinline__ unsigned xb_ld(unsigned* p)              { return __hip_atomic_load(p, __ATOMIC_RELAXED, __HIP_MEMORY_SCOPE_AGENT); }
__device__ __forceinline__ unsigned xb_add(unsigned* p, unsigned v) { return __hip_atomic_fetch_add(p, v, __ATOMIC_RELAXED, __HIP_MEMORY_SCOPE_AGENT); }
__device__ __forceinline__ unsigned xb_xcc_id() { return (unsigned)__builtin_amdgcn_s_getreg((3 << 11) | 20) & 0xFu; }
#define XB_SPIN(cond, bar) do { unsigned _sp = 0; while (cond) { __builtin_amdgcn_s_sleep(1); \
    if ((++_sp & 255u) == 0u) { if (xb_ld(&(bar)[XB_TMO])) break; if (_sp > XB_SPIN_CAP) { atomicAdd(&(bar)[XB_TMO], 1u); break; } } } } while (0)
struct XcdBarrier { unsigned* bar; unsigned x; volatile LAS unsigned* st; };
__device__ __forceinline__ XcdBarrier xcd_barrier_post(unsigned* bar, volatile LAS unsigned* st) {
    XcdBarrier b; b.bar = bar; b.x = xb_xcc_id(); b.st = st;
    if (threadIdx.x == 0) (void)xb_add(&bar[XB_XCNT(b.x)], 1u);
    return b;
}
__device__ __forceinline__ void xcd_barrier_complete(unsigned* bar, unsigned x, unsigned& nloc, unsigned& nx) {
    const unsigned G = gridDim.x * gridDim.y * gridDim.z;
    unsigned sum, cnt, mine, sp = 0u;
    for (;;) {
        sum = 0u; cnt = 0u; mine = 0u;
#pragma unroll
        for (unsigned j = 0; j < 16; ++j) { const unsigned c = xb_ld(&bar[XB_XCNT(j)]); sum += c; cnt += (c > 0u) ? 1u : 0u; mine = (j == x) ? c : mine; }
        if (sum == G) break;
        __builtin_amdgcn_s_sleep(1);
        if ((++sp & 255u) == 0u) { if (xb_ld(&bar[XB_TMO])) break; if (sp > XB_SPIN_CAP) { atomicAdd(&bar[XB_TMO], 1u); break; } }
    }
    nloc = mine > 0u ? mine : 1u; nx = cnt > 0u ? cnt : 1u;
}
__device__ __forceinline__ void xcd_barrier(const XcdBarrier& b) {
    asm volatile("s_waitcnt vmcnt(0)" ::: "memory");
    __syncthreads();
    if (threadIdx.x == 0) {
        unsigned* bar = b.bar;
        __builtin_amdgcn_s_waitcnt(0);
        unsigned nloc = b.st[0], nx = b.st[1];
        if (nloc == 0u) { xcd_barrier_complete(bar, b.x, nloc, nx); b.st[0] = nloc; b.st[1] = nx; }
        const unsigned old = xb_add(&bar[XB_XSUB(b.x)], 1u);
        const unsigned gen = old / nloc;
        if (old + 1u == (gen + 1u) * nloc) {
            __builtin_amdgcn_fence(__ATOMIC_RELEASE, "agent");
            asm volatile("s_waitcnt vmcnt(0)" ::: "memory");
            const unsigned og = xb_add(&bar[XB_TOP], 1u);
            const unsigned tg = og / nx;
            if (og + 1u == (tg + 1u) * nx) xb_add(&bar[XB_TOPGEN], 1u);
            else XB_SPIN(xb_ld(&bar[XB_TOPGEN]) == tg, bar);
            __builtin_amdgcn_fence(__ATOMIC_ACQUIRE, "agent");
            xb_add(&bar[XB_XGEN(b.x)], 1u);
            asm volatile("s_waitcnt vmcnt(0)" ::: "memory");
        } else {
            XB_SPIN(xb_ld(&bar[XB_XGEN(b.x)]) == gen, bar);
            __builtin_amdgcn_fence(__ATOMIC_ACQUIRE, "agent");
            asm volatile("s_waitcnt vmcnt(0)" ::: "memory");
        }
    }
    __syncthreads();
}

__global__ void __launch_bounds__(NTHR, 2) fwd_kernel(Args a) {
    extern __shared__ __attribute__((aligned(16))) unsigned char lds_raw[];
    cg::grid_group grid = cg::this_grid();
    LAS unsigned char* lds = (LAS unsigned char*)lds_raw;
    const int G = gridDim.x, bx = blockIdx.x;
    volatile LAS unsigned* xst = (volatile LAS unsigned*)(lds + RS_OFF + 2048);
    if (threadIdx.x < 4) xst[threadIdx.x] = 0u;
    __syncthreads();
    const XcdBarrier xbar = xcd_barrier_post((unsigned*)a.ws, xst);
    bool first_seam = true;

    bf16_t* WUP = (bf16_t*)(a.ws + WS_WUP); bf16_t* WDN = (bf16_t*)(a.ws + WS_WDN); bf16_t* WGLU = (bf16_t*)(a.ws + WS_WGLU);
    bf16_t* WQKV = (bf16_t*)(a.ws + WS_WQKV); bf16_t* WO = (bf16_t*)(a.ws + WS_WO);
    float* CS = (float*)(a.ws + WS_CS); bf16_t* XN = (bf16_t*)(a.ws + WS_XN); bf16_t* HID = (bf16_t*)(a.ws + WS_HID);
    bf16_t* AG = (bf16_t*)(a.ws + WS_AG); bf16_t* BTY = (bf16_t*)(a.ws + WS_BTY); bf16_t* BTS = (bf16_t*)(a.ws + WS_BTS); float* SL = (float*)(a.ws + WS_SL);
    bf16_t* QB = (bf16_t*)(a.ws + WS_Q); bf16_t* KB = (bf16_t*)(a.ws + WS_KB); bf16_t* VT = (bf16_t*)(a.ws + WS_VT); bf16_t* AO = (bf16_t*)(a.ws + WS_AO);
    bf16_t* ZB = (bf16_t*)(a.ws + WS_Z); float* SS = (float*)(a.ws + WS_SS);

    for (int rep = 0; rep < REP_P0; ++rep) {
        convert_weights(a, lds);
        cs_phase(a.pos, CS);
    }

    for (int layer = 0; layer < 4; ++layer) {
        const int j = layer >> 1; const bool is_s5 = (layer & 1) == 0;
        if (is_s5) {
            for (int rep = 0; rep < REP_NORM; ++rep) norm_phase(layer == 0 ? a.x : nullptr, XN, XN, a.s5_norm + (size_t)j * DM, AG);
            for (int rep = 0; rep < REP_TAB; ++rep)
                for (int it = bx; it < 256; it += G) s5_tables_item(lds, a, j, it >> 1, it & 1, BTY, BTS);
            if (first_seam) { grid.sync(); first_seam = false; } else GSYNC();
            {   pg8::Gemm g{AG, BTS, AGLD, 512, 512, 0}; pg8::TileOrder S; S.init(512, 1, G, bx, 4);
                pg8::EpiS5S E{SL};
                for (int rep = 0; rep < REP_S5G; ++rep) pg8::gemm_phase<pg8::EpiS5S>(lds, g, S, E);
            }
            GSYNC();
            for (int rep = 0; rep < REP_CARRY; ++rep) s5_carry_phase(a, j, SL, AG);
            GSYNC();
            {   pg8::Gemm g{AG, BTY, AGLD, AGLD, AGLD, 0}; pg8::TileOrder S; S.init(512, 2, G, bx, 4);
                pg8::EpiS5Y E{AG, a.s5_d + (size_t)j * DM, ZB};
                for (int rep = 0; rep < REP_S5G; ++rep) pg8::gemm_phase<pg8::EpiS5Y>(lds, g, S, E);
            }
            GSYNC();
            {   pg8::Gemm g{ZB, WGLU + (size_t)j * 4096 * DM, DM, DM, DM, 0}; pg8::TileOrder S; S.init(128, 16, G, bx, 0);
                pg8::EpiGlu E{XN, SS + (size_t)layer * SS_USE};
                pg8::gemm_phase<pg8::EpiGlu>(lds, g, S, E);
            }
            GSYNC();
        } else {
            {   pg8::Gemm g{XN, WQKV + (size_t)j * NQKV * DM, DM, DM, DM, 0}; pg8::TileOrder S; S.init(128, 10, G, bx, 0);
                pg8::EpiQKV E{QB, KB, VT, a.at_qg + j * 64, a.at_kg + j * 64, CS, SS + (size_t)(4 + j) * SS_USE};
                for (int rep = 0; rep < REP_QKV; ++rep) pg8::gemm_phase<pg8::EpiQKV>(lds, g, S, E);
            }
            GSYNC();
            for (int rep = 0; rep < REP_ATTN; ++rep) attn_phase(lds, QB, KB, VT, AO, a.at_sink + j * 32, a.at_qg + j * 64, a.at_kg + j * 64);
            GSYNC();
            {   pg8::Gemm g{AO, WO + (size_t)j * DM * DM, DM, DM, DM, 1}; pg8::TileOrder S; S.init(128, 8, G, bx, 0);
                pg8::EpiResidual E{XN, SS + (size_t)layer * SS_USE, nullptr}; pg8::gemm_phase<pg8::EpiResidual>(lds, g, S, E); }
            GSYNC();
        }
        {   pg8::Gemm g{XN, WUP + (size_t)layer * DFF * DM, DM, DM, DM, 0}; pg8::TileOrder S; S.init(128, 32, G, bx, 0);
            pg8::EpiSqRelu E{HID, DFF, SS + (size_t)layer * SS_USE, is_s5 ? 64 : 32};
            for (int rep = 0; rep < REP_UP; ++rep) pg8::gemm_phase<pg8::EpiSqRelu>(lds, g, S, E);
        }
        GSYNC();
        {   pg8::Gemm g{HID, WDN + (size_t)layer * DM * DFF, DFF, DFF, DFF, 1}; pg8::TileOrder S; S.init(128, 8, G, bx, 0);
            pg8::EpiResidual E{XN, is_s5 ? SS + (size_t)(4 + j) * SS_USE : nullptr, layer == 3 ? a.out : nullptr}; pg8::gemm_phase<pg8::EpiResidual>(lds, g, S, E); }
        GSYNC();
    }
}

extern "C" void kernel_launch(void* const* d_in, const int* in_sizes, int n_in, void* d_out, int out_size, void* d_ws, size_t ws_size, hipStream_t stream) {
    static int grid = 0;
    if (grid == 0) {
        if (n_in != 22 || out_size != MTOK * DM || ws_size < WS_END2) { fprintf(stderr, "kernel_launch: unexpected sizes n_in %d out %d ws %zu\n", n_in, out_size, ws_size); grid = -1; return; }
        int dev = 0, cus = 0, per_cu = 0;
        hipGetDevice(&dev);
        hipDeviceGetAttribute(&cus, hipDeviceAttributeMultiprocessorCount, dev);
        if (hipFuncSetAttribute((const void*)fwd_kernel, hipFuncAttributeMaxDynamicSharedMemorySize, LDS_BYTES) != hipSuccess) { fprintf(stderr, "kernel_launch: hipFuncSetAttribute failed\n"); grid = -1; return; }
        if (hipOccupancyMaxActiveBlocksPerMultiprocessor(&per_cu, (const void*)fwd_kernel, NTHR, LDS_BYTES) != hipSuccess || per_cu < 1) { fprintf(stderr, "kernel_launch: occupancy query gives %d\n", per_cu); per_cu = 1; }
        (void)hipGetLastError();
        grid = cus * 1;
        if (grid <= 0) { grid = -1; return; }
    }
    if (grid < 0) return;
    Args a{};
    a.x = (const float*)d_in[0]; a.pos = (const int*)d_in[1];
    a.s5_norm = (const float*)d_in[2]; a.s5_are = (const float*)d_in[3]; a.s5_aim = (const float*)d_in[4]; a.s5_ls = (const float*)d_in[5];
    a.s5_bre = (const float*)d_in[6]; a.s5_bim = (const float*)d_in[7]; a.s5_cre = (const float*)d_in[8]; a.s5_cim = (const float*)d_in[9];
    a.s5_d = (const float*)d_in[10]; a.s5_wa = (const float*)d_in[11]; a.s5_wb = (const float*)d_in[12];
    a.at_norm = (const float*)d_in[13]; a.at_wqkv = (const float*)d_in[14]; a.at_qg = (const float*)d_in[15]; a.at_kg = (const float*)d_in[16];
    a.at_sink = (const float*)d_in[17]; a.at_wo = (const float*)d_in[18];
    a.ml_norm = (const float*)d_in[19]; a.ml_wup = (const float*)d_in[20]; a.ml_wdn = (const float*)d_in[21];
    a.out = (float*)d_out; a.ws = (unsigned char*)d_ws;
    if (hipMemsetAsync(d_ws, 0, 16384, stream) != hipSuccess) { fprintf(stderr, "kernel_launch: hipMemsetAsync failed\n"); return; }
    void* args[] = {&a};
    hipError_t e = hipLaunchCooperativeKernel((const void*)fwd_kernel, dim3(grid), dim3(NTHR), args, LDS_BYTES, stream);
    if (e != hipSuccess) fprintf(stderr, "kernel_launch: cooperative launch failed: %s (grid %d)\n", hipGetErrorString(e), grid);
}
```
